# Optimizing an MI355X kernel written in HIP

```python
import math
import jax, jax.numpy as jnp
from jax import lax
import numpy as np

D_MODEL = 1024
BATCH = 4
SEQ = 4096
DEPTH = 2
DEC_BATCH = 128
DEC_SEQ = 4
PAST_LEN = 8192
PAGE_SIZE = 128

N_MIXERS = 2
N_ATTN_LAYERS = (DEPTH + 1) // 2
N_SSM_LAYERS = DEPTH // 2
RMS_EPS = 1e-6
N_HEADS = 16
N_KV_HEADS = 4
HEAD_DIM = 64
KV_REP = N_HEADS // N_KV_HEADS
WINDOW = 128
ATTN_BLOCK = WINDOW
NUM_BUCKETS = 32
MAX_DISTANCE = 128
SSM_EXPAND = 2
D_INNER = SSM_EXPAND * D_MODEL
SSM_HEAD_DIM = 64
SSM_HEADS = D_INNER // SSM_HEAD_DIM
SSM_GROUPS = 8
SSM_REP = SSM_HEADS // SSM_GROUPS
D_STATE = 128
SSM_CONV = 4
CONV_DIM = D_INNER + 2 * SSM_GROUPS * D_STATE
SSM_IN_DIM = D_INNER + CONV_DIM + SSM_HEADS
SSD_CHUNK = 128
D_FF = 2816
FFN_CONV = 3

kernel_name = 'hybrid_swa_sink_ssd_convffn_step'


def rmsnorm(x, g):
    xf = x.astype(jnp.float32)
    y = xf * lax.rsqrt(jnp.mean(xf * xf, axis=-1, keepdims=True) + RMS_EPS)
    return (y * g.astype(jnp.float32)).astype(x.dtype)


def causal_dwconv(x, buf, w, b):
    K = w.shape[0]
    L = x.shape[1]
    xp = jnp.concatenate([buf.astype(x.dtype), x], axis=1)
    y = b.astype(x.dtype)
    for k in range(K):
        y = y + xp[:, k:k + L] * w[k]
    return y, xp[:, L:]


def t5_bucket(dist):
    n = jnp.maximum(dist, 0)
    max_exact = NUM_BUCKETS // 2
    nf = jnp.maximum(n, 1).astype(jnp.float32)
    large = max_exact + (jnp.log(nf / max_exact) / math.log(MAX_DISTANCE / max_exact)
                         * (NUM_BUCKETS - max_exact)).astype(jnp.int32)
    large = jnp.minimum(large, NUM_BUCKETS - 1)
    return jnp.where(n < max_exact, n, large)


def rel_bias(dist, table):
    return jnp.transpose(table[t5_bucket(dist)], (2, 0, 1)).astype(jnp.float32)


def sink_attention(q, k, v, bias, mask, sinks):
    s = jnp.einsum('bnqgrd,bnkgd->bngrqk', q, k).astype(jnp.float32) * (HEAD_DIM ** -0.5)
    s = s + bias.reshape(N_KV_HEADS, KV_REP, *bias.shape[1:])
    s = jnp.where(mask[None, :, None, None], s, -jnp.inf)
    sink = sinks.astype(jnp.float32).reshape(N_KV_HEADS, KV_REP)[:, :, None, None]
    m = jnp.maximum(jnp.max(s, axis=-1, keepdims=True), sink)
    p = jnp.exp(s - m)
    p = p / (jnp.sum(p, axis=-1, keepdims=True) + jnp.exp(sink - m))
    return jnp.einsum('bngrqk,bnkgd->bnqgrd', p.astype(v.dtype), v)


def qkv_proj(h, wqkv):
    b, L, _ = h.shape
    qkv = h @ wqkv
    nq = N_HEADS * HEAD_DIM
    nk = N_KV_HEADS * HEAD_DIM
    q = qkv[..., :nq].reshape(b, L, N_KV_HEADS, KV_REP, HEAD_DIM)
    k = qkv[..., nq:nq + nk].reshape(b, L, N_KV_HEADS, HEAD_DIM)
    v = qkv[..., nq + nk:].reshape(b, L, N_KV_HEADS, HEAD_DIM)
    return q, k, v


def attn_prompt(h, wqkv, wo, sinks, table):
    b, L, _ = h.shape
    q, k, v = qkv_proj(h, wqkv)
    nb = L // ATTN_BLOCK
    pad = jnp.zeros((b, ATTN_BLOCK, N_KV_HEADS, HEAD_DIM), k.dtype)
    kp = jnp.concatenate([pad, k], axis=1)
    vp = jnp.concatenate([pad, v], axis=1)

    def band(t):
        tb = t.reshape(b, nb + 1, ATTN_BLOCK, N_KV_HEADS, HEAD_DIM)
        return jnp.concatenate([tb[:, :-1], tb[:, 1:]], axis=2)

    kj = jnp.arange(2 * ATTN_BLOCK)[None, :]
    dist = (jnp.arange(ATTN_BLOCK)[:, None] + ATTN_BLOCK) - kj
    kpos = jnp.arange(nb)[:, None, None] * ATTN_BLOCK - ATTN_BLOCK + kj[None]
    valid = (dist >= 0) & (dist < WINDOW) & (kpos >= 0)
    qb = q.reshape(b, nb, ATTN_BLOCK, N_KV_HEADS, KV_REP, HEAD_DIM)
    o = sink_attention(qb, band(kp), band(vp), rel_bias(dist, table), valid, sinks)
    y = o.reshape(b, L, N_HEADS * HEAD_DIM) @ wo
    return y, kp[:, -WINDOW:], vp[:, -WINDOW:]


def attn_sample(h, k_buf, v_buf, wqkv, wo, sinks, table):
    b, S, _ = h.shape
    wb = k_buf.shape[1]
    q, k, v = qkv_proj(h, wqkv)
    k_all = jnp.concatenate([k_buf.astype(k.dtype), k], axis=1)
    v_all = jnp.concatenate([v_buf.astype(v.dtype), v], axis=1)
    dist = (wb + jnp.arange(S))[:, None] - jnp.arange(wb + S)[None, :]
    valid = (dist >= 0) & (dist < WINDOW)
    o = sink_attention(q[:, None], k_all[:, None], v_all[:, None], rel_bias(dist, table), valid[None], sinks)
    y = o.reshape(b, S, N_HEADS * HEAD_DIM) @ wo
    return y, k_all[:, -wb:], v_all[:, -wb:]


def ssd_scan(x, dt, A, Bm, Cm, h0):
    b, L = x.shape[:2]
    T = SSD_CHUNK if L % SSD_CHUNK == 0 else L
    nc = L // T
    f32 = jnp.float32
    xc = x.astype(f32).reshape(b, nc, T, SSM_GROUPS, SSM_REP, SSM_HEAD_DIM)
    dtc = dt.reshape(b, nc, T, SSM_GROUPS, SSM_REP)
    Bc = Bm.astype(f32).reshape(b, nc, T, SSM_GROUPS, D_STATE)
    Cc = Cm.astype(f32).reshape(b, nc, T, SSM_GROUPS, D_STATE)
    cs = jnp.cumsum(dtc * A, axis=2)
    causal = (jnp.arange(T)[:, None] >= jnp.arange(T)[None, :])[:, :, None, None]
    seg = cs[:, :, :, None] - cs[:, :, None]
    lmat = jnp.exp(jnp.where(causal, seg, -jnp.inf))
    cb = jnp.einsum('bclgn,bcsgn->bclsg', Cc, Bc)
    w = cb[..., None] * lmat * dtc[:, :, None]
    y_diag = jnp.einsum('bclsgr,bcsgrp->bclgrp', w, xc)
    decay = jnp.exp(cs[:, :, -1:] - cs)
    states = jnp.einsum('bcsgn,bcsgr,bcsgrp->bcgrpn', Bc, decay * dtc, xc)
    chunk_decay = jnp.exp(cs[:, :, -1])

    def step(hc, inp):
        st, dec = inp
        return hc * dec[..., None, None] + st, hc

    h_final, h_prev = lax.scan(step, h0.astype(f32),
                               (jnp.moveaxis(states, 1, 0), jnp.moveaxis(chunk_decay, 1, 0)))
    h_prev = jnp.moveaxis(h_prev, 0, 1)
    y_off = jnp.einsum('bclgn,bcgrpn,bclgr->bclgrp', Cc, h_prev, jnp.exp(cs))
    y = (y_diag + y_off).reshape(b, L, SSM_GROUPS, SSM_REP, SSM_HEAD_DIM)
    return y, h_final


def ssd_mixer(h, conv_buf, ssm_state, w_in, conv_w, conv_b, dt_bias, A_log, D_skip, norm_w, w_out):
    b, L, _ = h.shape
    proj = h @ w_in
    z = proj[..., :D_INNER]
    xbc = proj[..., D_INNER:D_INNER + CONV_DIM]
    dt_raw = proj[..., D_INNER + CONV_DIM:]
    xbc_c, new_conv = causal_dwconv(xbc, conv_buf, conv_w, conv_b)
    xbc_c = jax.nn.silu(xbc_c)
    gn = SSM_GROUPS * D_STATE
    xs = xbc_c[..., :D_INNER].reshape(b, L, SSM_GROUPS, SSM_REP, SSM_HEAD_DIM)
    Bm = xbc_c[..., D_INNER:D_INNER + gn].reshape(b, L, SSM_GROUPS, D_STATE)
    Cm = xbc_c[..., D_INNER + gn:].reshape(b, L, SSM_GROUPS, D_STATE)
    dt = jax.nn.softplus(dt_raw.astype(jnp.float32) + dt_bias.astype(jnp.float32))
    dt = dt.reshape(b, L, SSM_GROUPS, SSM_REP)
    A = -jnp.exp(A_log.astype(jnp.float32)).reshape(SSM_GROUPS, SSM_REP)
    h0 = ssm_state.reshape(b, SSM_GROUPS, SSM_REP, SSM_HEAD_DIM, D_STATE)
    y, h_new = ssd_scan(xs, dt, A, Bm, Cm, h0)
    y = y + D_skip.astype(jnp.float32).reshape(SSM_GROUPS, SSM_REP)[:, :, None] * xs.astype(jnp.float32)
    y = y.reshape(b, L, D_INNER) * jax.nn.silu(z.astype(jnp.float32))
    yg = y.reshape(b, L, SSM_GROUPS, D_INNER // SSM_GROUPS)
    yg = yg * lax.rsqrt(jnp.mean(yg * yg, axis=-1, keepdims=True) + RMS_EPS)
    y = (yg.reshape(b, L, D_INNER) * norm_w.astype(jnp.float32)).astype(h.dtype)
    out = y @ w_out
    return out, new_conv, h_new.reshape(b, SSM_HEADS, SSM_HEAD_DIM, D_STATE).astype(ssm_state.dtype)


def conv_ffn(h, buf, w_up, conv_w, conv_b, w_down):
    u = h @ w_up
    u, new_buf = causal_dwconv(u, buf, conv_w, conv_b)
    return (jax.nn.silu(u[..., :D_FF]) * u[..., D_FF:]) @ w_down, new_buf


def run_trunk(x, cache_k, cache_v, st_conv, st_ssm, st_ffn,
              rel_bias_table, norm_mix, norm_ffn, norm_final,
              attn_wqkv, attn_wo, attn_sinks,
              ssm_w_in, ssm_conv_w, ssm_conv_b, ssm_dt_bias, ssm_A_log, ssm_D, ssm_norm, ssm_w_out,
              ffn_w_up, ffn_conv_w, ffn_conv_b, ffn_w_down):
    prompt = cache_k is None
    b = x.shape[0]
    new_k, new_v, new_conv, new_ssm, new_ffn = [], [], [], [], []
    for i in range(DEPTH):
        h = rmsnorm(x, norm_mix[i])
        if i % N_MIXERS == 0:
            a = i // N_MIXERS
            if prompt:
                o, kb, vb = attn_prompt(h, attn_wqkv[a], attn_wo[a], attn_sinks[a], rel_bias_table)
            else:
                o, kb, vb = attn_sample(h, cache_k[a], cache_v[a], attn_wqkv[a], attn_wo[a],
                                        attn_sinks[a], rel_bias_table)
            new_k.append(kb)
            new_v.append(vb)
        else:
            s = i // N_MIXERS
            cbuf = jnp.zeros((b, SSM_CONV - 1, CONV_DIM), x.dtype) if prompt else st_conv[s]
            hst = jnp.zeros((b, SSM_HEADS, SSM_HEAD_DIM, D_STATE), jnp.float32) if prompt else st_ssm[s]
            o, cb, hs = ssd_mixer(h, cbuf, hst, ssm_w_in[s], ssm_conv_w[s], ssm_conv_b[s], ssm_dt_bias[s],
                                  ssm_A_log[s], ssm_D[s], ssm_norm[s], ssm_w_out[s])
            new_conv.append(cb)
            new_ssm.append(hs)
        x = x + o
        h = rmsnorm(x, norm_ffn[i])
        fbuf = jnp.zeros((b, FFN_CONV - 1, 2 * D_FF), x.dtype) if prompt else st_ffn[i]
        o, fb = conv_ffn(h, fbuf, ffn_w_up[i], ffn_conv_w[i], ffn_conv_b[i], ffn_w_down[i])
        new_ffn.append(fb)
        x = x + o
    y = rmsnorm(x, norm_final)
    return (y, jnp.stack(new_k), jnp.stack(new_v), jnp.stack(new_conv), jnp.stack(new_ssm), jnp.stack(new_ffn))


def setup_inputs(seed: int = 0) -> dict:
    key = jax.random.key(seed)
    ks = jax.random.split(key, 32)
    f32 = jnp.float32

    def nrm(k, shape, scale):
        return scale * jax.random.normal(k, shape, f32)

    win_buf = min(WINDOW, PAST_LEN)
    qkv_dim = (N_HEADS + 2 * N_KV_HEADS) * HEAD_DIM
    dt0 = jnp.exp(jax.random.uniform(ks[17], (N_SSM_LAYERS, SSM_HEADS), f32, math.log(1e-3), math.log(1e-1)))
    return {
        'x_prompt': nrm(ks[0], (BATCH, SEQ, D_MODEL), 1.0),
        'x_sample': nrm(ks[1], (DEC_BATCH, DEC_SEQ, D_MODEL), 1.0),
        'cache_k_win': nrm(ks[2], (N_ATTN_LAYERS, DEC_BATCH, win_buf, N_KV_HEADS, HEAD_DIM), 1.0),
        'cache_v_win': nrm(ks[3], (N_ATTN_LAYERS, DEC_BATCH, win_buf, N_KV_HEADS, HEAD_DIM), 1.0),
        'state_ssm_conv': nrm(ks[4], (N_SSM_LAYERS, DEC_BATCH, SSM_CONV - 1, CONV_DIM), 1.0),
        'state_ssm': nrm(ks[5], (N_SSM_LAYERS, DEC_BATCH, SSM_HEADS, SSM_HEAD_DIM, D_STATE), 0.5),
        'state_ffn_conv': nrm(ks[6], (DEPTH, DEC_BATCH, FFN_CONV - 1, 2 * D_FF), 1.0),
        'rel_bias_table': nrm(ks[7], (NUM_BUCKETS, N_HEADS), 0.5),
        'norm_mix': 1.0 + nrm(ks[8], (DEPTH, D_MODEL), 0.02),
        'norm_ffn': 1.0 + nrm(ks[9], (DEPTH, D_MODEL), 0.02),
        'norm_final': 1.0 + nrm(ks[10], (D_MODEL,), 0.02),
        'attn_wqkv': nrm(ks[11], (N_ATTN_LAYERS, D_MODEL, qkv_dim), D_MODEL ** -0.5),
        'attn_wo': nrm(ks[12], (N_ATTN_LAYERS, N_HEADS * HEAD_DIM, D_MODEL), (N_HEADS * HEAD_DIM) ** -0.5),
        'attn_sinks': nrm(ks[13], (N_ATTN_LAYERS, N_HEADS), 0.5),
        'ssm_w_in': nrm(ks[14], (N_SSM_LAYERS, D_MODEL, SSM_IN_DIM), D_MODEL ** -0.5),
        'ssm_conv_w': nrm(ks[15], (N_SSM_LAYERS, SSM_CONV, CONV_DIM), SSM_CONV ** -0.5),
        'ssm_conv_b': nrm(ks[16], (N_SSM_LAYERS, CONV_DIM), 0.01),
        'ssm_dt_bias': dt0 + jnp.log(-jnp.expm1(-dt0)),
        'ssm_A_log': jnp.log(jax.random.uniform(ks[18], (N_SSM_LAYERS, SSM_HEADS), f32, 1.0, 16.0)),
        'ssm_D': 1.0 + nrm(ks[19], (N_SSM_LAYERS, SSM_HEADS), 0.1),
        'ssm_norm': 1.0 + nrm(ks[20], (N_SSM_LAYERS, D_INNER), 0.02),
        'ssm_w_out': nrm(ks[21], (N_SSM_LAYERS, D_INNER, D_MODEL), D_INNER ** -0.5),
        'ffn_w_up': nrm(ks[22], (DEPTH, D_MODEL, 2 * D_FF), D_MODEL ** -0.5),
        'ffn_conv_w': nrm(ks[23], (DEPTH, FFN_CONV, 2 * D_FF), FFN_CONV ** -0.5),
        'ffn_conv_b': nrm(ks[24], (DEPTH, 2 * D_FF), 0.01),
        'ffn_w_down': nrm(ks[25], (DEPTH, D_FF, D_MODEL), D_FF ** -0.5),
    }


def reference(x_prompt, x_sample, cache_k_win, cache_v_win, state_ssm_conv, state_ssm, state_ffn_conv,
              rel_bias_table, norm_mix, norm_ffn, norm_final,
              attn_wqkv, attn_wo, attn_sinks,
              ssm_w_in, ssm_conv_w, ssm_conv_b, ssm_dt_bias, ssm_A_log, ssm_D, ssm_norm, ssm_w_out,
              ffn_w_up, ffn_conv_w, ffn_conv_b, ffn_w_down):
    y_prompt, p_k, p_v, p_conv, p_ssm, p_ffn = run_trunk(
        x_prompt, None, None, None, None, None,
        rel_bias_table, norm_mix, norm_ffn, norm_final, attn_wqkv, attn_wo, attn_sinks,
        ssm_w_in, ssm_conv_w, ssm_conv_b, ssm_dt_bias, ssm_A_log, ssm_D, ssm_norm, ssm_w_out,
        ffn_w_up, ffn_conv_w, ffn_conv_b, ffn_w_down)
    y_sample, s_k, s_v, s_conv, s_ssm, s_ffn = run_trunk(
        x_sample, cache_k_win, cache_v_win, state_ssm_conv, state_ssm, state_ffn_conv,
        rel_bias_table, norm_mix, norm_ffn, norm_final, attn_wqkv, attn_wo, attn_sinks,
        ssm_w_in, ssm_conv_w, ssm_conv_b, ssm_dt_bias, ssm_A_log, ssm_D, ssm_norm, ssm_w_out,
        ffn_w_up, ffn_conv_w, ffn_conv_b, ffn_w_down)
    return (y_prompt, y_sample, p_k, p_v, p_conv, p_ssm, p_ffn, s_k, s_v, s_conv, s_ssm, s_ffn)
```

```cpp
#include <hip/hip_runtime.h>
#include <hip/hip_cooperative_groups.h>
#include <cstdio>
#include <cstdint>
namespace cg = cooperative_groups;

#define LAS __attribute__((address_space(3)))
typedef unsigned short bf16_t;
typedef short bf16x8 __attribute__((ext_vector_type(8)));
typedef short s16x4 __attribute__((ext_vector_type(4)));
typedef float f32x4 __attribute__((ext_vector_type(4)));
typedef float f32x2 __attribute__((ext_vector_type(2)));
typedef float f32x16 __attribute__((ext_vector_type(16)));
typedef unsigned u32x4 __attribute__((ext_vector_type(4)));
typedef unsigned u32x2 __attribute__((ext_vector_type(2)));
typedef __bf16 bf16x2_t __attribute__((ext_vector_type(2)));

constexpr int DM = 1024, NBATCH = 4, SEQ = 4096, MP = NBATCH * SEQ, SBATCH = 128, SLEN = 4, MS = SBATCH * SLEN, MT = MP + MS;
constexpr int NQKV = 1536, DFF = 2816, NUP = 2 * DFF, DIN = 2048, NCONV = 4096, NIN = 6176, NINP = 6400, NSH = 32, NSG = 8, DSTATE = 128;
constexpr int NCHUNK = SEQ / 128;
constexpr float RMS_EPS = 1e-6f;
constexpr float LOG2E = 1.4426950408889634f;

constexpr size_t MiB = 1u << 20;
constexpr size_t WS_CTL = 0;
constexpr size_t WS_PART = 1 * MiB;
constexpr size_t WS_BIASD = 3 * MiB;
constexpr size_t WS_CDEC = 3 * MiB + 65536;
constexpr size_t WS_DTRAW = 4 * MiB;
constexpr size_t WS_DT = 7 * MiB;
constexpr size_t WS_XS = 10 * MiB;
constexpr size_t WS_WQKV = 12 * MiB, WS_WO = 15 * MiB, WS_WIN = 17 * MiB, WS_WOUT = 30 * MiB, WS_WUP = 34 * MiB  , WS_WDN = 56 * MiB  ;
constexpr size_t WS_XR = 67 * MiB;
constexpr size_t WS_OV = 133 * MiB;
constexpr size_t WS_QKV = WS_OV, WS_AO = WS_OV + 50 * MiB;
constexpr size_t WS_U = WS_OV, WS_ACT = WS_OV + 182 * MiB;
constexpr size_t WS_Z = WS_OV, WS_XBC = WS_OV + 66 * MiB, WS_ST = WS_XBC;
constexpr size_t WS_XT = WS_OV + 198 * MiB;
constexpr size_t WS_BNCN = WS_OV + 262 * MiB;
constexpr size_t WS_BT = WS_OV + 328 * MiB;
constexpr size_t WS_XB = WS_BT;
constexpr size_t WS_END = WS_OV + 361 * MiB;
static_assert(WS_WQKV + (size_t)NQKV * DM * 2 <= WS_WO && WS_WO + (size_t)DM * DM * 2 <= WS_WIN && WS_WIN + (size_t)NINP * DM * 2 <= WS_WOUT && WS_WOUT + (size_t)DM * DIN * 2 <= WS_WUP &&
              WS_WUP + 2 * (size_t)NUP * DM * 2 <= WS_WDN && WS_WDN + 2 * (size_t)DM * DFF * 2 <= WS_XR && WS_XR + (size_t)MT * DM * 4 <= WS_OV, "weights map");
static_assert(WS_QKV + (size_t)MT * NQKV * 2 <= WS_AO && WS_U + (size_t)MT * NUP * 2 <= WS_ACT && WS_ACT + (size_t)MT * DFF * 2 <= WS_END && WS_Z + (size_t)MT * DIN * 2 <= WS_XBC &&
              WS_XBC + (size_t)MT * NCONV * 2 <= WS_XT && WS_ST + (size_t)MP * DIN * 4 <= WS_XT && WS_XT + (size_t)MP * DIN * 2 <= WS_BNCN && WS_BNCN + (size_t)MT * DIN * 2 <= WS_BT &&
              WS_BT + (size_t)MP * 1024 * 2 <= WS_END && WS_XB + (size_t)MT * DM * 2 <= WS_END && WS_PART + (size_t)MT * 64 <= WS_BIASD && WS_DTRAW + (size_t)MT * 128 <= WS_DT && WS_DT + (size_t)MT * 128 <= WS_XS, "overlay map");

constexpr size_t O_YP = 0, O_YS = O_YP + (size_t)MP * DM, O_PK = O_YS + (size_t)MS * DM, O_PV = O_PK + 4 * 128 * 256, O_PCONV = O_PV + 4 * 128 * 256, O_PSSM = O_PCONV + 4 * 3 * NCONV,
                 O_PFFN = O_PSSM + (size_t)4 * 32 * 64 * 128, O_SK = O_PFFN + 2 * 4 * 2 * NUP, O_SV = O_SK + (size_t)128 * 128 * 256, O_SCONV = O_SV + (size_t)128 * 128 * 256,
                 O_SSSM = O_SCONV + (size_t)128 * 3 * NCONV, O_SFFN = O_SSSM + (size_t)128 * 32 * 64 * 128, O_END = O_SFFN + (size_t)2 * 128 * 2 * NUP;

__device__ __forceinline__ float bf2f(unsigned v) { return __uint_as_float(v << 16); }
__device__ __forceinline__ unsigned pk2(float lo, float hi) { f32x2 v = {lo, hi}; bf16x2_t b = __builtin_convertvector(v, bf16x2_t); return __builtin_bit_cast(unsigned, b); }
__device__ __forceinline__ float wave_sum(float v) {
#pragma unroll
    for (int o = 1; o < 64; o <<= 1) v += __shfl_xor(v, o);
    return v;
}
__device__ __forceinline__ float wave_max(float v) {
#pragma unroll
    for (int o = 1; o < 64; o <<= 1) v = fmaxf(v, __shfl_xor(v, o));
    return v;
}
__device__ __forceinline__ float silu_f(float v) { return v / (1.0f + __expf(-v)); }
__device__ __forceinline__ int crow(int r, int hi) { return (r & 3) + 8 * (r >> 2) + 4 * hi; }
__device__ __forceinline__ void unpack8(const u32x4 v, float (&f)[8]) {
    f[0] = bf2f(v.x & 0xffffu); f[1] = bf2f(v.x >> 16); f[2] = bf2f(v.y & 0xffffu); f[3] = bf2f(v.y >> 16);
    f[4] = bf2f(v.z & 0xffffu); f[5] = bf2f(v.z >> 16); f[6] = bf2f(v.w & 0xffffu); f[7] = bf2f(v.w >> 16);
}
__device__ __forceinline__ u32x4 pack8(const float (&f)[8]) { u32x4 o; o.x = pk2(f[0], f[1]); o.y = pk2(f[2], f[3]); o.z = pk2(f[4], f[5]); o.w = pk2(f[6], f[7]); return o; }
__device__ __forceinline__ float row_rstd(const float* part, int row) {
    const f32x4* p = (const f32x4*)(part + (size_t)row * 16);
    const f32x4 a = p[0], b = p[1], c = p[2], d = p[3];
    const float s = ((a.x + a.y) + (a.z + a.w)) + ((b.x + b.y) + (b.z + b.w)) + ((c.x + c.y) + (c.z + c.w)) + ((d.x + d.y) + (d.z + d.w));
    return 1.0f / sqrtf(s * (1.0f / DM) + RMS_EPS);
}
namespace pg8 {
#define PG8_LAS __attribute__((address_space(3)))
typedef unsigned short bf16_t;
typedef short bf16x8 __attribute__((ext_vector_type(8)));
typedef float f32x4 __attribute__((ext_vector_type(4)));
typedef unsigned u32x4 __attribute__((ext_vector_type(4)));
constexpr int BM = 256, BK = 64, HALF = 128, HTB = HALF * BK * 2  , STAGE_BYTES = 8 * HTB, NXCD = 8, WGM = 8;

__host__ __device__ __forceinline__ int lds_byte(int r, int c) { const int st = (r >> 4) * 2 + (c >> 5), rr = r & 15, cc = c & 31, ob = rr * 64 + cc * 2; return st * 1024 + (ob ^ (((ob >> 9) & 1) << 5)); }
__host__ __device__ __forceinline__ void stage_rc(int b, int& R, int& C) { const int st = b / 1024, sb = b % 1024, swz = sb ^ (((sb >> 9) & 1) << 5); R = (st >> 1) * 16 + swz / 64; C = (st & 1) * 32 + (swz % 64) / 2; }
__host__ __device__ __forceinline__ int perm32(int rho) { const int n = rho >> 4, i = rho & 15; return 8 * (i >> 2) + 4 * n + (i & 3); }

struct Unit { int pm, pn; };
struct Gemm { const bf16_t* A; const bf16_t* Bt; int M, N, K; };

struct StaticOrder {
    int nM, nN, nwg, G, c;
    __host__ __device__ void init(int M, int N, int G_, int c_) { nM = M / BM; nN = N / BM; nwg = nM * nN; G = G_; c = c_; }
    __host__ __device__ bool next(int i, Unit& u) const {
        const long L = (long)i * G + c; if (L >= nwg) return false;
        int wgid = (int)L; { const int q = nwg / NXCD, r = nwg % NXCD, xcd = wgid % NXCD, off = wgid / NXCD; wgid = (xcd < r ? xcd * (q + 1) : r * (q + 1) + (xcd - r) * q) + off; }
        const int nig = WGM * nN, gid = wgid / nig, fm = gid * WGM, gsz = (nM - fm) < WGM ? (nM - fm) : WGM;
        u.pm = fm + ((wgid % nig) % gsz); u.pn = (wgid % nig) / gsz; return true;
    }
    __device__ __forceinline__ void a_ready(const Unit&) const {}
    __device__ __forceinline__ void done(const Unit&) const {}
};


template <int MODE> struct EpiScale {
    static constexpr bool PERM = true, AFTER_DRAIN = false;
    const float* part; bf16_t* O0; int ldc; bf16_t* O1; float* F;
    __device__ __forceinline__ void operator()(const f32x4 (&acc)[2][2][4][2], const Unit& u, int wr, int wc, int fr, int fq) const {
        const int colt = u.pn * BM; bf16_t* base = O0; int ld = ldc, cl = colt; bool dtile = false;
        if (MODE == 2) { if (colt < 2048) { base = O0; ld = 2048; cl = colt; } else if (colt < 6144) { base = O1; ld = 4096; cl = colt - 2048; } else { dtile = true; } }
        const int row0 = u.pm * BM + wr * 64 + fr, col0 = cl + wc * 32 + 8 * fq;
#pragma unroll
        for (int ai = 0; ai < 2; ++ai)
#pragma unroll
            for (int m = 0; m < 4; ++m) {
                const int row = row0 + ai * HALF + m * 16; const float rs = row_rstd(part, row);
                if (MODE == 2 && dtile) {
                    if (wc == 0) { float* fp = F + (size_t)row * 32 + 8 * fq; *(f32x4*)fp = acc[ai][0][m][0] * rs; *(f32x4*)(fp + 4) = acc[ai][0][m][1] * rs; }
                } else {
                    bf16_t* rowp = base + (size_t)row * ld + col0;
#pragma unroll
                    for (int bj = 0; bj < 2; ++bj) { const f32x4 v0 = acc[ai][bj][m][0] * rs, v1 = acc[ai][bj][m][1] * rs;
                        u32x4 w; w.x = pk2(v0[0], v0[1]); w.y = pk2(v0[2], v0[3]); w.z = pk2(v1[0], v1[1]); w.w = pk2(v1[2], v1[3]);
                        *(u32x4*)(rowp + bj * HALF) = w; }
                }
            }
    }
};
struct EpiResid {
    static constexpr bool PERM = true, AFTER_DRAIN = false;
    const float* xp; const float* xs; float* XR; bf16_t* XB; float* part;
    __device__ __forceinline__ void operator()(const f32x4 (&acc)[2][2][4][2], const Unit& u, int wr, int wc, int fr, int fq) const {
        const int row0 = u.pm * BM + wr * 64 + fr, col0 = u.pn * BM + wc * 32 + 8 * fq;
#pragma unroll
        for (int ai = 0; ai < 2; ++ai)
#pragma unroll
            for (int m = 0; m < 4; ++m) {
                const int row = row0 + ai * HALF + m * 16;
                const float* src = (xs != nullptr && row >= MP) ? xs + (size_t)(row - MP) * DM : xp + (size_t)row * DM;
                float ss = 0.f;
#pragma unroll
                for (int bj = 0; bj < 2; ++bj) { const int col = col0 + bj * HALF;
                    const f32x4 o0 = *(const f32x4*)(src + col), o1 = *(const f32x4*)(src + col + 4);
                    const f32x4 v0 = o0 + acc[ai][bj][m][0], v1 = o1 + acc[ai][bj][m][1];
                    float* dp = XR + (size_t)row * DM + col; *(f32x4*)dp = v0; *(f32x4*)(dp + 4) = v1;
                    ss += (v0[0] * v0[0] + v0[1] * v0[1]) + (v0[2] * v0[2] + v0[3] * v0[3]) + (v1[0] * v1[0] + v1[1] * v1[1]) + (v1[2] * v1[2] + v1[3] * v1[3]);
                    u32x4 w; w.x = pk2(v0[0], v0[1]); w.y = pk2(v0[2], v0[3]); w.z = pk2(v1[0], v1[1]); w.w = pk2(v1[2], v1[3]);
                    *(u32x4*)(XB + (size_t)row * DM + col) = w; }
                ss += __shfl_xor(ss, 16); ss += __shfl_xor(ss, 32);
                if (fq == 0) part[(size_t)row * 16 + u.pn * 4 + wc] = ss;
            }
    }
};

template <class Epi, class Sched, bool ALIGN_EPI = false, bool SP2 = false>
__device__ __forceinline__ void gemm_phase(PG8_LAS unsigned char* lds, const Gemm g, const Sched& S, const Epi& E) {
    const int tid = threadIdx.x, wid = __builtin_amdgcn_readfirstlane(tid >> 6), lane = tid & 63, wr = wid >> 2, wc = wid & 3, fr = lane & 15, fq = lane >> 4;
    const int K = g.K, nt = K / BK;
    unsigned voffA[2], voffB[2];
#pragma unroll
    for (int i = 0; i < 2; ++i) { int R, C; stage_rc(tid * 16 + i * 8192, R, C); const int Rb = Epi::PERM ? ((R & ~31) + perm32(R & 31)) : R;
        voffA[i] = (unsigned)(R * K + C) * 2u; voffB[i] = (unsigned)(Rb * K + C) * 2u; }
    const size_t kstep = (size_t)(BK * 2);
    const size_t hstep = (size_t)HALF * K * 2;
    const size_t tstep = 2 * hstep;
    const unsigned ldsw = (unsigned)wid * 1024u;
    const int aoff = lds_byte(wr * 64 + fr, fq * 8), boff = lds_byte(wc * 32 + fr, fq * 8);
#define PG8_SA(b, h) (((b) * 2 + (h)) * HTB)
#define PG8_SB(b, h) ((4 + (b) * 2 + (h)) * HTB)
#define PG8_STAGE(bufoff, gbase, voff) do { _Pragma("unroll") for (int _i = 0; _i < 2; ++_i) \
        __builtin_amdgcn_global_load_lds((const unsigned*)((const char*)(gbase) + (voff)[_i]), (PG8_LAS unsigned*)(lds + (bufoff) + ldsw + _i * 8192), 16, 0, 0); } while (0)
#define PG8_LDA(dst, b, h) do { _Pragma("unroll") for (int m = 0; m < 4; ++m) _Pragma("unroll") for (int k = 0; k < 2; ++k) dst[m][k] = *(const PG8_LAS bf16x8*)(lds + PG8_SA(b, h) + aoff + m * 2048 + k * 1024); } while (0)
#define PG8_LDB(dst, b, h) do { _Pragma("unroll") for (int n = 0; n < 2; ++n) _Pragma("unroll") for (int k = 0; k < 2; ++k) dst[n][k] = *(const PG8_LAS bf16x8*)(lds + PG8_SB(b, h) + boff + n * 2048 + k * 1024); } while (0)
#define PG8_MMA(ai, bj, At, Bt) do { __builtin_amdgcn_s_setprio(1); _Pragma("unroll") for (int m = 0; m < 4; ++m) _Pragma("unroll") for (int n = 0; n < 2; ++n) _Pragma("unroll") for (int k = 0; k < 2; ++k) \
        acc[ai][bj][m][n] = __builtin_amdgcn_mfma_f32_16x16x32_bf16(Bt[n][k], At[m][k], acc[ai][bj][m][n], 0, 0, 0); __builtin_amdgcn_s_setprio(0); } while (0)
#define PG8_WAIT_V(n) asm volatile("s_waitcnt vmcnt(" #n ")" ::: "memory")
#define PG8_WAIT_L(n) asm volatile("s_waitcnt lgkmcnt(" #n ")" ::: "memory")
#define PG8_BAR __builtin_amdgcn_s_barrier()
#define PG8_SCHED __builtin_amdgcn_sched_barrier(0)
    Unit cur, nxt; int ui = 0;
    if (!S.next(0, cur)) return;
    f32x4 acc[2][2][4][2];
#pragma unroll
    for (int a = 0; a < 2; ++a)
#pragma unroll
        for (int b = 0; b < 2; ++b)
#pragma unroll
            for (int m = 0; m < 4; ++m)
#pragma unroll
                for (int n = 0; n < 2; ++n) acc[a][b][m][n] = (f32x4){0.f, 0.f, 0.f, 0.f};
    bf16x8 At[4][2], B0[2][2], B1[2][2];
    const char* cA = (const char*)g.A + (size_t)cur.pm * tstep; const char* cB = (const char*)g.Bt + (size_t)cur.pn * tstep;
    S.a_ready(cur);
    if constexpr (SP2) {
        PG8_STAGE(PG8_SB(0, 0), cB, voffB); PG8_STAGE(PG8_SB(0, 1), cB + hstep, voffB); PG8_STAGE(PG8_SA(0, 0), cA, voffA); PG8_STAGE(PG8_SA(0, 1), cA + hstep, voffA);
        if (wr == 1) PG8_BAR;
        PG8_WAIT_V(2); PG8_BAR;
        PG8_STAGE(PG8_SB(1, 0), cB + kstep, voffB); PG8_STAGE(PG8_SA(1, 0), cA + kstep, voffA); PG8_STAGE(PG8_SB(1, 1), cB + hstep + kstep, voffB);
        PG8_WAIT_V(6); PG8_BAR;
    } else {
        PG8_STAGE(PG8_SB(0, 0), cB, voffB); PG8_STAGE(PG8_SA(0, 0), cA, voffA); PG8_STAGE(PG8_SB(0, 1), cB + hstep, voffB); PG8_STAGE(PG8_SA(0, 1), cA + hstep, voffA);
        if (wr == 1) PG8_BAR;
        PG8_WAIT_V(4); PG8_BAR;
        PG8_STAGE(PG8_SB(1, 0), cB + kstep, voffB); PG8_STAGE(PG8_SA(1, 0), cA + kstep, voffA); PG8_STAGE(PG8_SB(1, 1), cB + hstep + kstep, voffB);
        PG8_WAIT_V(6); PG8_BAR;
    }
    for (;;) {
        const bool has_next = S.next(ui + 1, nxt);
        const char* nA = has_next ? (const char*)g.A + (size_t)nxt.pm * tstep : cA; const char* nB = has_next ? (const char*)g.Bt + (size_t)nxt.pn * tstep : cB;
        for (int t = 0; t < nt; t += 2) {
            const bool last = (t == nt - 2);
            const char* a1 = cA + (size_t)(t + 1) * kstep;
            const char* a2 = last ? nA : cA + (size_t)(t + 2) * kstep; const char* b2 = last ? nB : cB + (size_t)(t + 2) * kstep;
            const char* a3 = a2 + kstep; const char* b3 = b2 + kstep;
            if (last && has_next) S.a_ready(nxt);
            if constexpr (SP2) {
            PG8_LDB(B0, 0, 0); PG8_LDB(B1, 0, 1); PG8_SCHED; PG8_LDA(At, 0, 0); PG8_STAGE(PG8_SA(1, 1), a1 + hstep, voffA);
            PG8_WAIT_V(8); PG8_WAIT_L(0); PG8_BAR; PG8_MMA(0, 0, At, B0); PG8_MMA(0, 1, At, B1); PG8_BAR; PG8_SCHED;
            PG8_LDA(At, 0, 1); PG8_STAGE(PG8_SB(0, 0), b2, voffB); PG8_STAGE(PG8_SB(0, 1), b2 + hstep, voffB); PG8_STAGE(PG8_SA(0, 0), a2, voffA);
            PG8_WAIT_V(8); PG8_WAIT_L(0); PG8_BAR; PG8_MMA(1, 0, At, B0); PG8_MMA(1, 1, At, B1); PG8_BAR; PG8_SCHED;
            PG8_LDB(B0, 1, 0); PG8_LDB(B1, 1, 1); PG8_SCHED; PG8_LDA(At, 1, 0); PG8_STAGE(PG8_SA(0, 1), a2 + hstep, voffA);
            PG8_WAIT_V(8); PG8_WAIT_L(0); PG8_BAR; PG8_MMA(0, 0, At, B0); PG8_MMA(0, 1, At, B1); PG8_BAR; PG8_SCHED;
            PG8_LDA(At, 1, 1); PG8_STAGE(PG8_SB(1, 0), b3, voffB); PG8_STAGE(PG8_SB(1, 1), b3 + hstep, voffB); PG8_STAGE(PG8_SA(1, 0), a3, voffA);
            PG8_WAIT_V(8); PG8_WAIT_L(0); PG8_BAR; PG8_MMA(1, 0, At, B0); PG8_MMA(1, 1, At, B1); PG8_BAR; PG8_SCHED;
            } else {
            PG8_LDB(B0, 0, 0); PG8_SCHED; PG8_LDA(At, 0, 0); PG8_STAGE(PG8_SA(1, 1), a1 + hstep, voffA);
            PG8_WAIT_L(8); PG8_BAR; PG8_WAIT_L(0); PG8_MMA(0, 0, At, B0); PG8_BAR; PG8_SCHED;
            PG8_LDB(B1, 0, 1); PG8_STAGE(PG8_SB(0, 0), b2, voffB);
            PG8_BAR; PG8_WAIT_L(0); PG8_MMA(0, 1, At, B1); PG8_BAR;
            PG8_LDA(At, 0, 1); PG8_STAGE(PG8_SA(0, 0), a2, voffA);
            PG8_BAR; PG8_WAIT_L(0); PG8_MMA(1, 0, At, B0); PG8_BAR; PG8_SCHED;
            PG8_STAGE(PG8_SB(0, 1), b2 + hstep, voffB);
            PG8_WAIT_V(6); PG8_BAR; PG8_MMA(1, 1, At, B1); PG8_BAR;
            PG8_LDB(B0, 1, 0); PG8_SCHED; PG8_LDA(At, 1, 0); PG8_STAGE(PG8_SA(0, 1), a2 + hstep, voffA);
            PG8_WAIT_L(8); PG8_BAR; PG8_WAIT_L(0); PG8_MMA(0, 0, At, B0); PG8_BAR; PG8_SCHED;
            PG8_LDB(B1, 1, 1); PG8_STAGE(PG8_SB(1, 0), b3, voffB);
            PG8_BAR; PG8_WAIT_L(0); PG8_MMA(0, 1, At, B1); PG8_BAR;
            PG8_LDA(At, 1, 1); PG8_STAGE(PG8_SA(1, 0), a3, voffA);
            PG8_BAR; PG8_WAIT_L(0); PG8_MMA(1, 0, At, B0); PG8_BAR; PG8_SCHED;
            PG8_STAGE(PG8_SB(1, 1), b3 + hstep, voffB);
            PG8_WAIT_V(6); PG8_BAR; PG8_MMA(1, 1, At, B1); PG8_BAR;
            }
        }
        if constexpr (ALIGN_EPI) { if (wr == 0) PG8_BAR; }
        if constexpr (!Epi::AFTER_DRAIN) { E(acc, cur, wr, wc, fr, fq); S.done(cur); }
        if (!has_next) break;
#pragma unroll
        for (int a = 0; a < 2; ++a)
#pragma unroll
            for (int b = 0; b < 2; ++b)
#pragma unroll
                for (int m = 0; m < 4; ++m)
#pragma unroll
                    for (int n = 0; n < 2; ++n) acc[a][b][m][n] = (f32x4){0.f, 0.f, 0.f, 0.f};
        cur = nxt; cA = nA; cB = nB; ++ui;
        if constexpr (ALIGN_EPI) { if (wr == 1) PG8_BAR; }
    }
    PG8_WAIT_V(0);
    if constexpr (!ALIGN_EPI) { if (wr == 0) PG8_BAR; }
    PG8_BAR;
    if constexpr (Epi::AFTER_DRAIN) { E.fused(acc, cur, wr, wc, fr, fq, lds, wid, lane); S.done(cur); }
#undef PG8_SA
#undef PG8_SB
#undef PG8_STAGE
#undef PG8_LDA
#undef PG8_LDB
#undef PG8_MMA
#undef PG8_WAIT_V
#undef PG8_WAIT_L
#undef PG8_BAR
#undef PG8_SCHED
}
}

constexpr int NWAVES = 8, NTHREADS = 512;
constexpr int RING_BYTES = 131072, LDS_BYTES = 155648;
struct Args { const float* in[26]; float* out; unsigned char* ws; int ph_lo, ph_hi, coop, pad; };
struct Ctx {
    const float* in[26]; float* out; unsigned char* ws; LAS unsigned char* lds; int tid, lane, wave, G, bid;
    float* PART; float* BIASD; float* CDEC; float* DTRAW; float* DT; bf16_t* XS; bf16_t *WQKV, *WO, *WIN, *WOUT, *WUP, *WDN; float* XR; bf16_t *QKV, *AO, *U, *ACT, *Z, *XBC; float* ST; bf16_t *XT, *BNCN, *BT, *XB;
};
enum { I_XP = 0, I_XS, I_CK, I_CV, I_SCONV, I_SSSM, I_SFFN, I_RELB, I_NMIX, I_NFFN, I_NFIN, I_WQKV, I_WO, I_SINK, I_WIN, I_CW, I_CB, I_DTB, I_ALOG, I_SD, I_SNORM, I_WOUT, I_WUP, I_FCW, I_FCB, I_WDN };

__device__ __forceinline__ int t5_bucket(int n) {
    if (n < 16) return n;
    int b = 16;
    b += (n >= 19); b += (n >= 21); b += (n >= 24); b += (n >= 27); b += (n >= 31); b += (n >= 35); b += (n >= 40); b += (n >= 46); b += (n >= 52); b += (n >= 59); b += (n >= 67); b += (n >= 77); b += (n >= 87); b += (n >= 99); b += (n >= 113);
    return b;
}

__device__ __forceinline__ void p0_transpose_item(const float* W, int K, int N, bf16_t* WT, const float* gain, LAS float* scr, int item, int lane) {
    const int nblk = N / 32, kb = item / nblk, nb = item % nblk, k0 = 64 * kb, n0 = 32 * nb;
#pragma unroll 8
    for (int i = 0; i < 32; ++i) { const int kk = 2 * i + (lane >> 5); float v = W[(size_t)(k0 + kk) * N + n0 + (lane & 31)]; if (gain) v *= gain[k0 + kk]; scr[kk * 33 + (lane & 31)] = v; }
    asm volatile("s_waitcnt lgkmcnt(0)" ::: "memory");
    const int c = lane & 7;
#pragma unroll
    for (int j = 0; j < 4; ++j) { const int n = (lane >> 3) + 8 * j; const LAS float* s = scr + (8 * c) * 33 + n;
        u32x4 o; o.x = pk2(s[0 * 33], s[1 * 33]); o.y = pk2(s[2 * 33], s[3 * 33]); o.z = pk2(s[4 * 33], s[5 * 33]); o.w = pk2(s[6 * 33], s[7 * 33]);
        *(u32x4*)(WT + (size_t)(n0 + n) * K + k0 + 8 * c) = o; }
    asm volatile("s_waitcnt lgkmcnt(0)" ::: "memory");
}
__device__ __forceinline__ void phase_prologue(const Ctx& C) {
    LAS float* scr = (LAS float*)(C.lds + C.wave * 16384);
    const int gw = C.bid * NWAVES + C.wave, NGW = C.G * NWAVES;
    constexpr int I0 = (DM / 64) * (NQKV / 32), I1 = (DM / 64) * (DM / 32), I2 = (DM / 64) * (NIN / 32), I3 = (DIN / 64) * (DM / 32), I4 = (DM / 64) * (NUP / 32), I5 = (DFF / 64) * (DM / 32);
    constexpr int NITEMS = I0 + I1 + I2 + I3 + 2 * I4 + 2 * I5;
    for (int it = gw; it < NITEMS; it += NGW) {
        int r = it;
        if (r < I0) { p0_transpose_item(C.in[I_WQKV], DM, NQKV, C.WQKV, C.in[I_NMIX], scr, r, C.lane); continue; } r -= I0;
        if (r < I1) { p0_transpose_item(C.in[I_WO], DM, DM, C.WO, nullptr, scr, r, C.lane); continue; } r -= I1;
        if (r < I2) { p0_transpose_item(C.in[I_WIN], DM, NIN, C.WIN, C.in[I_NMIX] + DM, scr, r, C.lane); continue; } r -= I2;
        if (r < I3) { p0_transpose_item(C.in[I_WOUT], DIN, DM, C.WOUT, C.in[I_SNORM], scr, r, C.lane); continue; } r -= I3;
        if (r < I4) { p0_transpose_item(C.in[I_WUP], DM, NUP, C.WUP, C.in[I_NFFN], scr, r, C.lane); continue; } r -= I4;
        if (r < I4) { p0_transpose_item(C.in[I_WUP] + (size_t)DM * NUP, DM, NUP, C.WUP + (size_t)NUP * DM, C.in[I_NFFN] + DM, scr, r, C.lane); continue; } r -= I4;
        if (r < I5) { p0_transpose_item(C.in[I_WDN], DFF, DM, C.WDN, nullptr, scr, r, C.lane); continue; } r -= I5;
        p0_transpose_item(C.in[I_WDN] + (size_t)DFF * DM, DFF, DM, C.WDN + (size_t)DM * DFF, nullptr, scr, r, C.lane);
    }
    { const int gt = C.bid * NTHREADS + C.tid, NGT = C.G * NTHREADS; u32x4* z = (u32x4*)(C.WIN + (size_t)NIN * DM);
      for (int i = gt; i < (NINP - NIN) * DM / 8; i += NGT) z[i] = (u32x4){0u, 0u, 0u, 0u}; }
    for (int m = gw; m < MT; m += NGW) {
        const float* xrow = (m < MP) ? C.in[I_XP] + (size_t)m * DM : C.in[I_XS] + (size_t)(m - MP) * DM;
        const f32x4* xr = (const f32x4*)xrow + C.lane; f32x4 v[4]; float s = 0.f;
#pragma unroll
        for (int j = 0; j < 4; ++j) { v[j] = xr[64 * j]; s += (v[j].x * v[j].x + v[j].y * v[j].y) + (v[j].z * v[j].z + v[j].w * v[j].w); }
        s = wave_sum(s);
        u32x2* o8 = (u32x2*)(C.XB + (size_t)m * DM) + C.lane;
#pragma unroll
        for (int j = 0; j < 4; ++j) { u32x2 w; w.x = pk2(v[j].x, v[j].y); w.y = pk2(v[j].z, v[j].w); o8[64 * j] = w; }
        if (C.lane < 16) C.PART[(size_t)m * 16 + C.lane] = (C.lane == 0) ? s : 0.f;
    }
    { const int gt = C.bid * NTHREADS + C.tid; if (gt < 16 * 128) { const int h = gt >> 7, d = gt & 127; C.BIASD[gt] = C.in[I_RELB][t5_bucket(d) * 16 + h] * LOG2E; } }
}

#define MFMA32(a, b, c) __builtin_amdgcn_mfma_f32_32x32x16_bf16((a), (b), (c), 0, 0, 0)
__device__ __forceinline__ f32x16 zero16() { f32x16 z; for (int i = 0; i < 16; ++i) z[i] = 0.f; return z; }

__device__ __forceinline__ void attn_prompt_unit(const Ctx& C, int b, int c, int g) {
    LAS bf16_t* Ks = (LAS bf16_t*)C.lds;
    LAS bf16_t* Vt = (LAS bf16_t*)(C.lds + 36864);
    LAS float* Bd = (LAS float*)(C.lds + 36864 + 33792);
    const int tid = C.tid, lane = C.lane, w = C.wave;
#pragma unroll
    for (int i = 0; i < 4; ++i) {
        const int id = i * NTHREADS + tid, row = id >> 3, ch = id & 7, kpos = (c - 1) * 128 + row;
        u32x4 kv = (u32x4){0u, 0u, 0u, 0u}, vv = (u32x4){0u, 0u, 0u, 0u};
        if (kpos >= 0) { const bf16_t* src = C.QKV + (size_t)(b * SEQ + kpos) * NQKV + 1024 + g * 64 + ch * 8; kv = *(const u32x4*)src; vv = *(const u32x4*)(src + 256); }
        *(LAS u32x4*)(Ks + row * 72 + ch * 8) = kv;
        const int prow = (row & ~15) | ((row & 3) + 4 * ((row >> 3) & 1) + 8 * ((row >> 2) & 1));
        LAS bf16_t* vd = Vt + (ch * 8) * 264 + prow;
        vd[0 * 264] = (bf16_t)(vv.x & 0xffffu); vd[1 * 264] = (bf16_t)(vv.x >> 16); vd[2 * 264] = (bf16_t)(vv.y & 0xffffu); vd[3 * 264] = (bf16_t)(vv.y >> 16);
        vd[4 * 264] = (bf16_t)(vv.z & 0xffffu); vd[5 * 264] = (bf16_t)(vv.z >> 16); vd[6 * 264] = (bf16_t)(vv.w & 0xffffu); vd[7 * 264] = (bf16_t)(vv.w >> 16);
    }
    Bd[tid] = C.BIASD[(g * 4 + (tid >> 7)) * 128 + (tid & 127)];
    __syncthreads();
    const int r = w >> 1, ph = w & 1, hh = g * 4 + r, ql = lane & 31, hi = lane >> 5;
    const float sink2 = C.in[I_SINK][hh] * LOG2E;
    const int jmin = (c == 0) ? 128 : 0;
    for (int qg = 0; qg < 2; ++qg) {
        const int q0 = ph * 64 + qg * 32, qi = q0 + ql, t0 = q0 >> 5;
        const size_t qrow = (size_t)(b * SEQ + c * 128 + qi);
        bf16x8 qf[4];
#pragma unroll
        for (int s = 0; s < 4; ++s) qf[s] = *(const bf16x8*)(C.QKV + qrow * NQKV + hh * 64 + 16 * s + 8 * hi);
        f32x16 S[5];
#pragma unroll
        for (int kk = 0; kk < 5; ++kk) {
            S[kk] = zero16();
#pragma unroll
            for (int s = 0; s < 4; ++s) { const bf16x8 kf = *(const LAS bf16x8*)(Ks + (32 * (t0 + kk) + ql) * 72 + 16 * s + 8 * hi); S[kk] = MFMA32(kf, qf[s], S[kk]); }
        }
        float mx = sink2; const int dbase = qi + 128 - 32 * t0;
#pragma unroll
        for (int kk = 0; kk < 5; ++kk)
#pragma unroll
            for (int rr = 0; rr < 16; ++rr) {
                const int jl = 32 * kk + crow(rr, hi), d = dbase - jl, j = 32 * t0 + jl;
                const bool ok = (d >= 0) && (d < 128) && (j >= jmin);
                float v = S[kk][rr] * (0.125f * LOG2E) + Bd[r * 128 + (d & 127)];
                v = ok ? v : -INFINITY; S[kk][rr] = v; mx = fmaxf(mx, v);
            }
        mx = fmaxf(mx, __shfl_xor(mx, 32));
        float l = 0.f;
#pragma unroll
        for (int kk = 0; kk < 5; ++kk)
#pragma unroll
            for (int rr = 0; rr < 16; ++rr) { const float p = __builtin_amdgcn_exp2f(S[kk][rr] - mx); S[kk][rr] = p; l += p; }
        l += __shfl_xor(l, 32); l += __builtin_amdgcn_exp2f(sink2 - mx);
        const float inv = 1.0f / l;
        f32x16 O[2]; O[0] = zero16(); O[1] = zero16();
#pragma unroll
        for (int kk = 0; kk < 5; ++kk)
#pragma unroll
            for (int ks = 0; ks < 2; ++ks) {
                u32x4 pw; pw.x = pk2(S[kk][8 * ks + 0], S[kk][8 * ks + 1]); pw.y = pk2(S[kk][8 * ks + 2], S[kk][8 * ks + 3]); pw.z = pk2(S[kk][8 * ks + 4], S[kk][8 * ks + 5]); pw.w = pk2(S[kk][8 * ks + 6], S[kk][8 * ks + 7]);
                const bf16x8 pf = __builtin_bit_cast(bf16x8, pw);
#pragma unroll
                for (int dt = 0; dt < 2; ++dt) { const bf16x8 vf = *(const LAS bf16x8*)(Vt + (32 * dt + ql) * 264 + 32 * (t0 + kk) + 16 * ks + 8 * hi); O[dt] = MFMA32(vf, pf, O[dt]); }
            }
#pragma unroll
        for (int dt = 0; dt < 2; ++dt)
#pragma unroll
            for (int q4 = 0; q4 < 4; ++q4) {
                u32x2 wv; wv.x = pk2(O[dt][4 * q4] * inv, O[dt][4 * q4 + 1] * inv); wv.y = pk2(O[dt][4 * q4 + 2] * inv, O[dt][4 * q4 + 3] * inv);
                *(u32x2*)(C.AO + qrow * DM + hh * 64 + 32 * dt + 8 * q4 + 4 * hi) = wv;
            }
    }
    if (c == NCHUNK - 1) {
#pragma unroll
        for (int i = 0; i < 2; ++i) {
            const int id = i * NTHREADS + tid, wq = id >> 3, ch = id & 7;
            const bf16_t* src = C.QKV + (size_t)(b * SEQ + SEQ - 128 + wq) * NQKV + 1024 + g * 64 + ch * 8;
            float kf[8], vf[8]; unpack8(*(const u32x4*)src, kf); unpack8(*(const u32x4*)(src + 256), vf);
            float* ok = C.out + O_PK + ((size_t)(b * 128 + wq) * 4 + g) * 64 + ch * 8; float* ov = C.out + O_PV + ((size_t)(b * 128 + wq) * 4 + g) * 64 + ch * 8;
            *(f32x4*)ok = (f32x4){kf[0], kf[1], kf[2], kf[3]}; *(f32x4*)(ok + 4) = (f32x4){kf[4], kf[5], kf[6], kf[7]};
            *(f32x4*)ov = (f32x4){vf[0], vf[1], vf[2], vf[3]}; *(f32x4*)(ov + 4) = (f32x4){vf[4], vf[5], vf[6], vf[7]};
        }
    }
    __syncthreads();
}
__device__ __forceinline__ void attn_sample_unit(const Ctx& C, int b, int g) {
    LAS float* Kc = (LAS float*)C.lds;
    LAS float* Vc = Kc + 132 * 65;
    LAS float* Qs = Vc + 132 * 65;
    LAS float* Ps = Qs + 16 * 64;
    const int tid = C.tid, lane = C.lane, w = C.wave;
    const float* ck = C.in[I_CK]; const float* cv = C.in[I_CV];
#pragma unroll
    for (int i = 0; i < 4; ++i) {
        const int id = i * NTHREADS + tid, wq = id >> 4, ch = id & 15; const size_t off = ((size_t)(b * 128 + wq) * 4 + g) * 64 + ch * 4;
        const f32x4 kv = *(const f32x4*)(ck + off), vv = *(const f32x4*)(cv + off);
        LAS float* kd = Kc + wq * 65 + ch * 4; LAS float* vd = Vc + wq * 65 + ch * 4;
        kd[0] = kv.x; kd[1] = kv.y; kd[2] = kv.z; kd[3] = kv.w; vd[0] = vv.x; vd[1] = vv.y; vd[2] = vv.z; vd[3] = vv.w;
        if (wq >= 4) { const size_t oo = ((size_t)(b * 128 + wq - 4) * 4 + g) * 64 + ch * 4; *(f32x4*)(C.out + O_SK + oo) = kv; *(f32x4*)(C.out + O_SV + oo) = vv; }
    }
    { const int isv = tid >> 8, s = (tid >> 6) & 3, d = tid & 63;
      const float val = bf2f(C.QKV[(size_t)(MP + b * 4 + s) * NQKV + 1024 + isv * 256 + g * 64 + d]);
      (isv ? Vc : Kc)[(128 + s) * 65 + d] = val;
      C.out[(isv ? O_SV : O_SK) + ((size_t)(b * 128 + 124 + s) * 4 + g) * 64 + d] = val; }
#pragma unroll
    for (int i = 0; i < 2; ++i) { const int id = i * NTHREADS + tid, qr = id >> 6, d = id & 63, r = qr >> 2, s = qr & 3;
        Qs[id] = bf2f(C.QKV[(size_t)(MP + b * 4 + s) * NQKV + (g * 4 + r) * 64 + d]); }
    __syncthreads();
    for (int id = tid; id < 16 * 132; id += NTHREADS) {
        const int qr = id / 132, key = id - qr * 132, r = qr >> 2, s = qr & 3, dist = 128 + s - key;
        float acc = 0.f;
#pragma unroll 16
        for (int d = 0; d < 64; ++d) acc += Qs[qr * 64 + d] * Kc[key * 65 + d];
        const bool ok = (dist >= 0) && (dist < 128);
        Ps[id] = ok ? acc * (0.125f * LOG2E) + C.BIASD[(g * 4 + r) * 128 + (dist & 127)] : -INFINITY;
    }
    __syncthreads();
#pragma unroll
    for (int qq = 0; qq < 2; ++qq) {
        const int qr = 2 * w + qq, r = qr >> 2; const float sink2 = C.in[I_SINK][g * 4 + r] * LOG2E;
        LAS float* pr = Ps + qr * 132;
        const float v0 = pr[lane], v1 = pr[64 + lane], v2 = (lane < 4) ? pr[128 + lane] : -INFINITY;
        const float mx = fmaxf(wave_max(fmaxf(fmaxf(v0, v1), v2)), sink2);
        const float p0 = __builtin_amdgcn_exp2f(v0 - mx), p1 = __builtin_amdgcn_exp2f(v1 - mx), p2 = __builtin_amdgcn_exp2f(v2 - mx);
        const float l = wave_sum(p0 + p1 + p2) + __builtin_amdgcn_exp2f(sink2 - mx), inv = 1.0f / l;
        pr[lane] = p0 * inv; pr[64 + lane] = p1 * inv; if (lane < 4) pr[128 + lane] = p2 * inv;
    }
    __syncthreads();
    { const int qr = tid >> 5, d = (tid & 31) * 2, r = qr >> 2, s = qr & 3; float o0 = 0.f, o1 = 0.f;
      for (int key = 0; key < 132; ++key) { const float p = Ps[qr * 132 + key]; o0 += p * Vc[key * 65 + d]; o1 += p * Vc[key * 65 + d + 1]; }
      *(unsigned*)(C.AO + (size_t)(MP + b * 4 + s) * DM + (g * 4 + r) * 64 + d) = pk2(o0, o1); }
    __syncthreads();
}
__device__ __forceinline__ void phase_attention(const Ctx& C) {
    for (int u = C.bid; u < 1024; u += C.G) {
        if (u < 512) attn_prompt_unit(C, u >> 7, (u >> 2) & 31, u & 3);
        else attn_sample_unit(C, (u - 512) >> 2, u & 3);
    }
}

__device__ __forceinline__ void phase_ffn_act(const Ctx& C, int layer) {
    const int cg = C.tid & 31, rs = C.tid >> 5;
    const float* cw = C.in[I_FCW] + (size_t)layer * 3 * NUP; const float* cb = C.in[I_FCB] + (size_t)layer * NUP;
    const float* st = C.in[I_SFFN] + (size_t)layer * SBATCH * 2 * NUP;
    for (int it = C.bid; it < (MT / 128) * (DFF / 256); it += C.G) {
        const int rb = it / (DFF / 256), cbk = it - rb * (DFF / 256);
        const int j0 = cbk * 256 + cg * 8, m0 = rb * 128 + rs * 8; const bool samp = (m0 >= MP);
        float wa[3][8], wb[3][8], ba[8], bb[8];
#pragma unroll
        for (int k = 0; k < 3; ++k)
#pragma unroll
            for (int e = 0; e < 8; ++e) { wa[k][e] = cw[k * NUP + j0 + e]; wb[k][e] = cw[k * NUP + DFF + j0 + e]; }
#pragma unroll
        for (int e = 0; e < 8; ++e) { ba[e] = cb[j0 + e]; bb[e] = cb[DFF + j0 + e]; }
        float a2[8], a1[8], b2[8], b1[8];
#pragma unroll
        for (int e = 0; e < 8; ++e) { a2[e] = 0.f; a1[e] = 0.f; b2[e] = 0.f; b1[e] = 0.f; }
        if (!samp && (m0 & (SEQ - 1)) != 0) {
            const bf16_t* up = C.U + (size_t)(m0 - 2) * NUP + j0;
            unpack8(*(const u32x4*)up, a2); unpack8(*(const u32x4*)(up + DFF), b2); unpack8(*(const u32x4*)(up + NUP), a1); unpack8(*(const u32x4*)(up + NUP + DFF), b1);
        }
#pragma unroll
        for (int i = 0; i < 8; ++i) {
            const int m = m0 + i;
            if (samp && ((m - MP) & 3) == 0) {
                const float* sp = st + (size_t)((m - MP) >> 2) * 2 * NUP + j0;
#pragma unroll
                for (int e = 0; e < 8; ++e) { a2[e] = sp[e]; b2[e] = sp[DFF + e]; a1[e] = sp[NUP + e]; b1[e] = sp[NUP + DFF + e]; }
            }
            float ca[8], cbv[8];
            const bf16_t* up = C.U + (size_t)m * NUP + j0;
            unpack8(*(const u32x4*)up, ca); unpack8(*(const u32x4*)(up + DFF), cbv);
            float o[8];
#pragma unroll
            for (int e = 0; e < 8; ++e) {
                const float ya = ba[e] + wa[0][e] * a2[e] + wa[1][e] * a1[e] + wa[2][e] * ca[e];
                const float yb = bb[e] + wb[0][e] * b2[e] + wb[1][e] * b1[e] + wb[2][e] * cbv[e];
                o[e] = silu_f(ya) * yb;
            }
            *(u32x4*)(C.ACT + (size_t)m * DFF + j0) = pack8(o);
            int k = -1; size_t ob = 0;
            if (!samp) { const int t = m & (SEQ - 1); if (t >= SEQ - 2) { k = t - (SEQ - 2); ob = O_PFFN + ((size_t)(layer * NBATCH + (m >> 12)) * 2 + k) * NUP; } }
            else { const int s = (m - MP) & 3; if (s >= 2) { k = s - 2; ob = O_SFFN + ((size_t)(layer * SBATCH + ((m - MP) >> 2)) * 2 + k) * NUP; } }
            if (k >= 0) {
                float* oa = C.out + ob + j0; float* obp = oa + DFF;
                *(f32x4*)oa = (f32x4){ca[0], ca[1], ca[2], ca[3]}; *(f32x4*)(oa + 4) = (f32x4){ca[4], ca[5], ca[6], ca[7]};
                *(f32x4*)obp = (f32x4){cbv[0], cbv[1], cbv[2], cbv[3]}; *(f32x4*)(obp + 4) = (f32x4){cbv[4], cbv[5], cbv[6], cbv[7]};
            }
#pragma unroll
            for (int e = 0; e < 8; ++e) { a2[e] = a1[e]; a1[e] = ca[e]; b2[e] = b1[e]; b1[e] = cbv[e]; }
        }
    }
}

__device__ __forceinline__ void phase_ssm_conv(const Ctx& C) {
    const int cg = C.tid & 31, rs = C.tid >> 5;
    LAS unsigned* T = (LAS unsigned*)C.lds;
    const float* cw = C.in[I_CW]; const float* cbias = C.in[I_CB]; const float* st = C.in[I_SCONV];
    for (int it = C.bid; it < (MT / 128) * (NCONV / 256); it += C.G) {
        const int rb = it >> 4, cbk = it & 15;
        const int c0 = cbk * 256 + cg * 8, m0 = rb * 128 + rs * 8; const bool samp = (m0 >= MP);
        const bool trans = !samp && cbk < 12;
        float wv[4][8], bv[8];
#pragma unroll
        for (int k = 0; k < 4; ++k)
#pragma unroll
            for (int e = 0; e < 8; ++e) wv[k][e] = cw[k * NCONV + c0 + e];
#pragma unroll
        for (int e = 0; e < 8; ++e) bv[e] = cbias[c0 + e];
        float a3[8], a2[8], a1[8];
#pragma unroll
        for (int e = 0; e < 8; ++e) { a3[e] = 0.f; a2[e] = 0.f; a1[e] = 0.f; }
        if (!samp && (m0 & (SEQ - 1)) != 0) {
            const bf16_t* xp = C.XBC + (size_t)(m0 - 3) * NCONV + c0;
            unpack8(*(const u32x4*)xp, a3); unpack8(*(const u32x4*)(xp + NCONV), a2); unpack8(*(const u32x4*)(xp + 2 * NCONV), a1);
        }
#pragma unroll
        for (int i = 0; i < 8; ++i) {
            const int m = m0 + i;
            if (samp && ((m - MP) & 3) == 0) {
                const float* sp = st + (size_t)((m - MP) >> 2) * 3 * NCONV + c0;
#pragma unroll
                for (int e = 0; e < 8; ++e) { a3[e] = sp[e]; a2[e] = sp[NCONV + e]; a1[e] = sp[2 * NCONV + e]; }
            }
            float cur[8], o[8];
            unpack8(*(const u32x4*)(C.XBC + (size_t)m * NCONV + c0), cur);
#pragma unroll
            for (int e = 0; e < 8; ++e) o[e] = silu_f(bv[e] + wv[0][e] * a3[e] + wv[1][e] * a2[e] + wv[2][e] * a1[e] + wv[3][e] * cur[e]);
            const u32x4 ow = pack8(o);
            if (cbk >= 8) *(u32x4*)(C.BNCN + (size_t)m * DIN + (c0 - 2048)) = ow;
            else if (samp) *(u32x4*)(C.XS + (size_t)(m - MP) * DIN + c0) = ow;
            if (trans) { LAS unsigned* tp = T + (rs * 8 + i) * 133 + cg * 4; tp[0] = ow.x; tp[1] = ow.y; tp[2] = ow.z; tp[3] = ow.w; }
            int k = -1; size_t ob = 0;
            if (!samp) { const int t = m & (SEQ - 1); if (t >= SEQ - 3) { k = t - (SEQ - 3); ob = O_PCONV + ((size_t)(m >> 12) * 3 + k) * NCONV; } }
            else { const int s = (m - MP) & 3; if (s >= 1) { k = s - 1; ob = O_SCONV + ((size_t)((m - MP) >> 2) * 3 + k) * NCONV; } }
            if (k >= 0) { float* op = C.out + ob + c0; *(f32x4*)op = (f32x4){cur[0], cur[1], cur[2], cur[3]}; *(f32x4*)(op + 4) = (f32x4){cur[4], cur[5], cur[6], cur[7]}; }
#pragma unroll
            for (int e = 0; e < 8; ++e) { a3[e] = a2[e]; a2[e] = a1[e]; a1[e] = cur[e]; }
        }
        if (trans) {
            __syncthreads();
            const LAS bf16_t* Tb = (const LAS bf16_t*)T;
#pragma unroll
            for (int i = 0; i < 8; ++i) {
                const int id = i * NTHREADS + C.tid, tseg = id & 15, col = id >> 4;
                unsigned short e[8];
#pragma unroll
                for (int q = 0; q < 8; ++q) e[q] = Tb[(tseg * 8 + q) * 266 + col];
                u32x4 ow; ow.x = e[0] | ((unsigned)e[1] << 16); ow.y = e[2] | ((unsigned)e[3] << 16); ow.z = e[4] | ((unsigned)e[5] << 16); ow.w = e[6] | ((unsigned)e[7] << 16);
                if (cbk < 8) *(u32x4*)(C.XT + ((size_t)(rb * 32 + cbk * 4 + (col >> 6)) * 64 + (col & 63)) * 128 + tseg * 8) = ow;
                else *(u32x4*)(C.BT + ((size_t)(rb * 8 + (cbk - 8) * 2 + (col >> 7)) * 128 + (col & 127)) * 128 + tseg * 8) = ow;
            }
            __syncthreads();
        }
    }
    { const int gt = C.bid * NTHREADS + C.tid, NGT = C.G * NTHREADS; const float* dtb = C.in[I_DTB];
      for (int i = gt; i < MT * 32; i += NGT) { const float x = C.DTRAW[i] + dtb[i & 31]; C.DT[i] = (x > 20.f) ? x : log1pf(__expf(x)); } }
}

__device__ __forceinline__ void phase_final_norm(const Ctx& C) {
    const int gw = C.bid * NWAVES + C.wave, NGW = C.G * NWAVES; const f32x4* gp = (const f32x4*)C.in[I_NFIN] + C.lane;
    f32x4 gv[4];
#pragma unroll
    for (int j = 0; j < 4; ++j) gv[j] = gp[64 * j];
    for (int m = gw; m < MT; m += NGW) {
        const float rs = row_rstd(C.PART, m);
        const f32x4* xr = (const f32x4*)(C.XR + (size_t)m * DM) + C.lane;
        f32x4* o = (f32x4*)(C.out + (m < MP ? O_YP + (size_t)m * DM : O_YS + (size_t)(m - MP) * DM)) + C.lane;
#pragma unroll
        for (int j = 0; j < 4; ++j) o[64 * j] = xr[64 * j] * rs * gv[j];
    }
}

__device__ __forceinline__ void chunk_scan(const float* dtp  , float A, int lane, float& cs0, float& cs1, float& d0, float& d1, float& tot) {
    d0 = dtp[(size_t)(2 * lane) * 32]; d1 = dtp[(size_t)(2 * lane + 1) * 32];
    const float a0 = d0 * A, a1 = d1 * A; float inc = a0 + a1;
#pragma unroll
    for (int o = 1; o < 64; o <<= 1) { const float v = __shfl_up(inc, o); if (lane >= o) inc += v; }
    cs1 = inc; cs0 = inc - a1; tot = __shfl(inc, 63);
}
__device__ __forceinline__ void ssd_states_unit(const Ctx& C, int rb, int g) {
    const int w = C.wave, lane = C.lane, r = w >> 1, phalf = w & 1, h = g * 4 + r, ql = lane & 31, hi = lane >> 5;
    LAS float* F = (LAS float*)C.lds + w * 128;
    const float A = -__expf(C.in[I_ALOG][h]);
    float cs0, cs1, d0, d1, tot; chunk_scan(C.DT + (size_t)(rb * 128) * 32 + h, A, lane, cs0, cs1, d0, d1, tot);
    F[2 * lane] = __expf(tot - cs0) * d0; F[2 * lane + 1] = __expf(tot - cs1) * d1;
    if (phalf == 0 && lane == 0) C.CDEC[rb * 32 + h] = __expf(tot);
    asm volatile("s_waitcnt lgkmcnt(0)" ::: "memory");
    f32x16 acc[4];
#pragma unroll
    for (int nt = 0; nt < 4; ++nt) acc[nt] = zero16();
    const bf16_t* xrow = C.XT + ((size_t)(rb * 32 + h) * 64 + phalf * 32 + ql) * 128 + 8 * hi;
    const bf16_t* brow = C.BT + ((size_t)(rb * 8 + g) * 128 + ql) * 128 + 8 * hi;
#pragma unroll
    for (int s = 0; s < 8; ++s) {
        float xf[8]; unpack8(*(const u32x4*)(xrow + 16 * s), xf);
        const f32x4 f0 = *(const LAS f32x4*)(F + 16 * s + 8 * hi), f1 = *(const LAS f32x4*)(F + 16 * s + 8 * hi + 4);
        xf[0] *= f0.x; xf[1] *= f0.y; xf[2] *= f0.z; xf[3] *= f0.w; xf[4] *= f1.x; xf[5] *= f1.y; xf[6] *= f1.z; xf[7] *= f1.w;
        const bf16x8 af = __builtin_bit_cast(bf16x8, pack8(xf));
#pragma unroll
        for (int nt = 0; nt < 4; ++nt) { const bf16x8 bfr = *(const bf16x8*)(brow + (size_t)nt * 32 * 128 + 16 * s); acc[nt] = MFMA32(af, bfr, acc[nt]); }
    }
    float* stp = C.ST + ((size_t)(rb * 32 + h) * 64 + phalf * 32) * 128 + ql;
#pragma unroll
    for (int nt = 0; nt < 4; ++nt)
#pragma unroll
        for (int rg = 0; rg < 16; ++rg) stp[(size_t)crow(rg, hi) * 128 + nt * 32] = acc[nt][rg];
}
__device__ __forceinline__ void ssd_sample_unit(const Ctx& C, int b, int g) {
    LAS float* Bs = (LAS float*)C.lds;
    LAS float* Cs = Bs + 512;
    LAS float* Xs = Cs + 512;
    LAS float* Dts = Xs + 1024;
    LAS float* Css = Dts + 16;
    LAS float* Cbm = Css + 16;
    LAS float* Yt = Cbm + 16;
    LAS float* Red = Yt + 1024;
    const int tid = C.tid, lane = C.lane, w = C.wave; const size_t m0 = (size_t)MP + b * 4;
    __syncthreads();
    { const int t = tid >> 7, n = tid & 127; Bs[tid] = bf2f(C.BNCN[(m0 + t) * DIN + g * 128 + n]); Cs[tid] = bf2f(C.BNCN[(m0 + t) * DIN + 1024 + g * 128 + n]); }
#pragma unroll
    for (int i = 0; i < 2; ++i) { const int id = i * NTHREADS + tid, hl = id >> 8, t = (id >> 6) & 3, p = id & 63; Xs[id] = bf2f(C.XS[(size_t)(b * 4 + t) * DIN + (g * 4 + hl) * 64 + p]); }
    if (tid < 16) Dts[tid] = C.DT[(m0 + (tid & 3)) * 32 + g * 4 + (tid >> 2)];
    __syncthreads();
    if (tid < 4) { const float A = -__expf(C.in[I_ALOG][g * 4 + tid]); float c = 0.f;
#pragma unroll
        for (int t = 0; t < 4; ++t) { c += Dts[tid * 4 + t] * A; Css[tid * 4 + t] = c; } }
    { const int pair = tid >> 5, l32 = tid & 31, t = pair >> 2, s = pair & 3; float a = 0.f;
#pragma unroll
      for (int k = 0; k < 4; ++k) a += Cs[t * 128 + l32 * 4 + k] * Bs[s * 128 + l32 * 4 + k];
#pragma unroll
      for (int o = 1; o < 32; o <<= 1) a += __shfl_xor(a, o);
      if (l32 == 0) Cbm[pair] = a; }
    __syncthreads();
    const int p = tid >> 3, ns = tid & 7;
    for (int hl = 0; hl < 4; ++hl) {
        const int h = g * 4 + hl; const size_t so = ((size_t)(b * 32 + h) * 64 + p) * 128 + ns * 16;
        const float* sin = C.in[I_SSSM] + so; float* sout = C.out + O_SSSM + so;
        f32x4 hv[4];
#pragma unroll
        for (int k = 0; k < 4; ++k) hv[k] = *(const f32x4*)(sin + 4 * k);
        float cst[4], dtt[4], xv[4], coef[4], yo[4];
#pragma unroll
        for (int t = 0; t < 4; ++t) { cst[t] = Css[hl * 4 + t]; dtt[t] = Dts[hl * 4 + t]; xv[t] = Xs[(hl * 4 + t) * 64 + p]; }
        const float cdec = __expf(cst[3]);
#pragma unroll
        for (int t = 0; t < 4; ++t) { coef[t] = __expf(cst[3] - cst[t]) * dtt[t] * xv[t]; yo[t] = 0.f; }
#pragma unroll
        for (int k = 0; k < 4; ++k) {
            f32x4 hn = hv[k] * cdec;
#pragma unroll
            for (int t = 0; t < 4; ++t) {
                const f32x4 cv = *(const LAS f32x4*)(Cs + t * 128 + ns * 16 + 4 * k), bv = *(const LAS f32x4*)(Bs + t * 128 + ns * 16 + 4 * k);
                yo[t] += (cv.x * hv[k].x + cv.y * hv[k].y) + (cv.z * hv[k].z + cv.w * hv[k].w);
                hn += bv * coef[t];
            }
            *(f32x4*)(sout + 4 * k) = hn;
        }
#pragma unroll
        for (int t = 0; t < 4; ++t) { yo[t] += __shfl_xor(yo[t], 1); yo[t] += __shfl_xor(yo[t], 2); yo[t] += __shfl_xor(yo[t], 4); }
        if (ns == 0) {
            const float Dh = C.in[I_SD][h];
#pragma unroll
            for (int t = 0; t < 4; ++t) {
                float y = __expf(cst[t]) * yo[t] + Dh * xv[t];
#pragma unroll
                for (int s = 0; s < 4; ++s) if (s <= t) y += Cbm[t * 4 + s] * __expf(cst[t] - cst[s]) * dtt[s] * xv[s];
                Yt[t * 256 + hl * 64 + p] = y;
            }
        }
    }
    __syncthreads();
    { const int t = tid >> 7, ch = (tid & 127) * 2; const size_t zo = (m0 + t) * DIN + g * 256 + ch;
      const unsigned zz = *(const unsigned*)(C.Z + zo);
      const float v0 = Yt[t * 256 + ch] * silu_f(bf2f(zz & 0xffffu)), v1 = Yt[t * 256 + ch + 1] * silu_f(bf2f(zz >> 16));
      const float ss = wave_sum(v0 * v0 + v1 * v1);
      if (lane == 0) Red[w] = ss;
      __syncthreads();
      const float rn = 1.0f / sqrtf((Red[2 * t] + Red[2 * t + 1]) * (1.0f / 256.0f) + RMS_EPS);
      *(unsigned*)(C.Z + zo) = pk2(v0 * rn, v1 * rn); }
    __syncthreads();
}
__device__ __forceinline__ void phase_ssd_states(const Ctx& C) {
    for (int u = C.bid; u < 2048; u += C.G) {
        if (u < 1024) ssd_states_unit(C, u >> 3, u & 7);
        else ssd_sample_unit(C, (u - 1024) >> 3, u & 7);
    }
}
__device__ __forceinline__ void phase_ssd_scan(const Ctx& C) {
    const int gt = C.bid * NTHREADS + C.tid, NGT = C.G * NTHREADS;
    for (int id = gt; id < NBATCH * NSH * 64 * 32; id += NGT) {
        const int n4 = id & 31, p = (id >> 5) & 63, h = (id >> 11) & 31, b = id >> 16;
        f32x4 hs = (f32x4){0.f, 0.f, 0.f, 0.f};
#pragma unroll 8
        for (int c = 0; c < NCHUNK; ++c) {
            float* ptr = C.ST + ((size_t)((b * NCHUNK + c) * NSH + h) * 64 + p) * 128 + n4 * 4;
            const f32x4 s = *(const f32x4*)ptr; *(f32x4*)ptr = hs;
            hs = hs * C.CDEC[(b * NCHUNK + c) * NSH + h] + s;
        }
        *(f32x4*)(C.out + O_PSSM + ((size_t)(b * NSH + h) * 64 + p) * 128 + n4 * 4) = hs;
    }
}
__device__ __forceinline__ void ssd_out_unit(const Ctx& C, int rb, int g) {
    const int w = C.wave, lane = C.lane, r = w >> 1, lh = w & 1, h = g * 4 + r, ql = lane & 31, hi = lane >> 5;
    LAS float* CS = (LAS float*)C.lds + w * 256; LAS float* DTL = CS + 128;
    LAS float* SSQ = (LAS float*)C.lds + 8 * 256;
    const float A = -__expf(C.in[I_ALOG][h]), Dh = C.in[I_SD][h];
    { float cs0, cs1, d0, d1, tot; chunk_scan(C.DT + (size_t)(rb * 128) * 32 + h, A, lane, cs0, cs1, d0, d1, tot);
      CS[2 * lane] = cs0; CS[2 * lane + 1] = cs1; DTL[2 * lane] = d0; DTL[2 * lane + 1] = d1; }
    asm volatile("s_waitcnt lgkmcnt(0)" ::: "memory");
    const size_t row0 = (size_t)rb * 128;
    const bf16_t* xt = C.XT + ((size_t)(rb * 32 + h) * 64 + ql) * 128;
    for (int lq = 0; lq < 2; ++lq) {
        const int lt = 2 * lh + lq, l = 32 * lt + ql; const size_t lrow = row0 + l;
        bf16x8 cf[8];
#pragma unroll
        for (int k = 0; k < 8; ++k) cf[k] = *(const bf16x8*)(C.BNCN + lrow * DIN + 1024 + g * 128 + 16 * k + 8 * hi);
        const float csl = CS[l];
        f32x16 Y[2]; Y[0] = zero16(); Y[1] = zero16();
        for (int st = 0; st <= lt; ++st) {
            f32x16 cb = zero16(); const bf16_t* bp = C.BNCN + (row0 + 32 * st + ql) * DIN + g * 128 + 8 * hi;
#pragma unroll
            for (int k = 0; k < 8; ++k) { const bf16x8 bfr = *(const bf16x8*)(bp + 16 * k); cb = MFMA32(bfr, cf[k], cb); }
            float wv[16];
#pragma unroll
            for (int q4 = 0; q4 < 4; ++q4) {
                const int sb = 32 * st + 8 * q4 + 4 * hi;
                const f32x4 cs4 = *(const LAS f32x4*)(CS + sb), dt4 = *(const LAS f32x4*)(DTL + sb);
#pragma unroll
                for (int e = 0; e < 4; ++e) { const int s = sb + e; float v = cb[4 * q4 + e] * __expf(csl - cs4[e]) * dt4[e]; v = (s <= l) ? v : 0.f; if (s == l) v += Dh; wv[4 * q4 + e] = v; }
            }
            bf16x8 pf[2];
#pragma unroll
            for (int ks = 0; ks < 2; ++ks) { u32x4 pw; pw.x = pk2(wv[8 * ks], wv[8 * ks + 1]); pw.y = pk2(wv[8 * ks + 2], wv[8 * ks + 3]); pw.z = pk2(wv[8 * ks + 4], wv[8 * ks + 5]); pw.w = pk2(wv[8 * ks + 6], wv[8 * ks + 7]); pf[ks] = __builtin_bit_cast(bf16x8, pw); }
#pragma unroll
            for (int pt = 0; pt < 2; ++pt)
#pragma unroll
                for (int ks = 0; ks < 2; ++ks) {
                    const bf16_t* xp = xt + (size_t)pt * 32 * 128 + 32 * st + 16 * ks + 4 * hi;
                    const u32x2 lo = *(const u32x2*)xp, hi2 = *(const u32x2*)(xp + 8);
                    const bf16x8 xf = __builtin_bit_cast(bf16x8, ((u32x4){lo.x, lo.y, hi2.x, hi2.y}));
                    Y[pt] = MFMA32(xf, pf[ks], Y[pt]);
                }
        }
        const float el = __expf(csl);
#pragma unroll
        for (int pt = 0; pt < 2; ++pt) {
            f32x16 y2 = zero16(); const float* hp = C.ST + ((size_t)(rb * 32 + h) * 64 + 32 * pt + ql) * 128 + 8 * hi;
#pragma unroll
            for (int k = 0; k < 8; ++k) { const f32x4 h0 = *(const f32x4*)(hp + 16 * k), h1 = *(const f32x4*)(hp + 16 * k + 4);
                u32x4 pw; pw.x = pk2(h0.x, h0.y); pw.y = pk2(h0.z, h0.w); pw.z = pk2(h1.x, h1.y); pw.w = pk2(h1.z, h1.w);
                y2 = MFMA32(__builtin_bit_cast(bf16x8, pw), cf[k], y2); }
#pragma unroll
            for (int rg = 0; rg < 16; ++rg) Y[pt][rg] += el * y2[rg];
        }
        float ss = 0.f;
#pragma unroll
        for (int pt = 0; pt < 2; ++pt)
#pragma unroll
            for (int q4 = 0; q4 < 4; ++q4) {
                const u32x2 zz = *(const u32x2*)(C.Z + lrow * DIN + h * 64 + 32 * pt + 8 * q4 + 4 * hi);
                const float z0 = bf2f(zz.x & 0xffffu), z1 = bf2f(zz.x >> 16), z2 = bf2f(zz.y & 0xffffu), z3 = bf2f(zz.y >> 16);
                float v;
                v = Y[pt][4 * q4 + 0] * silu_f(z0); Y[pt][4 * q4 + 0] = v; ss += v * v;
                v = Y[pt][4 * q4 + 1] * silu_f(z1); Y[pt][4 * q4 + 1] = v; ss += v * v;
                v = Y[pt][4 * q4 + 2] * silu_f(z2); Y[pt][4 * q4 + 2] = v; ss += v * v;
                v = Y[pt][4 * q4 + 3] * silu_f(z3); Y[pt][4 * q4 + 3] = v; ss += v * v;
            }
        ss += __shfl_xor(ss, 32);
        if (hi == 0) SSQ[r * 128 + l] = ss;
        __syncthreads();
        const float tot = (SSQ[l] + SSQ[128 + l]) + (SSQ[256 + l] + SSQ[384 + l]);
        const float rn = 1.0f / sqrtf(tot * (1.0f / 256.0f) + RMS_EPS);
#pragma unroll
        for (int pt = 0; pt < 2; ++pt)
#pragma unroll
            for (int q4 = 0; q4 < 4; ++q4) {
                u32x2 ov; ov.x = pk2(Y[pt][4 * q4] * rn, Y[pt][4 * q4 + 1] * rn); ov.y = pk2(Y[pt][4 * q4 + 2] * rn, Y[pt][4 * q4 + 3] * rn);
                *(u32x2*)(C.Z + lrow * DIN + h * 64 + 32 * pt + 8 * q4 + 4 * hi) = ov;
            }
    }
    __syncthreads();
}
__device__ __forceinline__ void phase_ssd_out(const Ctx& C) {
    for (int u = C.bid; u < 1024; u += C.G) ssd_out_unit(C, u >> 3, u & 7);
}

#ifndef MK_ONE_LAUNCH
#define MK_ONE_LAUNCH 0
#endif
constexpr int N_PHASES = 17;
template <class Epi> __device__ __forceinline__ void run_gemm(const Ctx& C, const bf16_t* A, const bf16_t* Bt, int N, int K, const Epi& E) {
    pg8::Gemm g{A, Bt, MT, N, K}; pg8::StaticOrder S; S.init(MT, N, C.G, C.bid);
    pg8::gemm_phase<Epi, pg8::StaticOrder, true, true>(C.lds, g, S, E);
}
__global__ void __launch_bounds__(NTHREADS, 2) hybrid_fwd(Args a) {
    extern __shared__ __attribute__((aligned(16))) unsigned char lds_raw[];
    Ctx C;
#pragma unroll
    for (int i = 0; i < 26; ++i) C.in[i] = a.in[i];
    C.out = a.out; C.ws = a.ws; C.lds = (LAS unsigned char*)lds_raw;
    C.tid = threadIdx.x; C.lane = C.tid & 63; C.wave = __builtin_amdgcn_readfirstlane(C.tid >> 6); C.G = gridDim.x; C.bid = blockIdx.x;
    unsigned char* ws = a.ws;
    C.PART = (float*)(ws + WS_PART); C.BIASD = (float*)(ws + WS_BIASD); C.CDEC = (float*)(ws + WS_CDEC); C.DTRAW = (float*)(ws + WS_DTRAW); C.DT = (float*)(ws + WS_DT); C.XS = (bf16_t*)(ws + WS_XS);
    C.WQKV = (bf16_t*)(ws + WS_WQKV); C.WO = (bf16_t*)(ws + WS_WO); C.WIN = (bf16_t*)(ws + WS_WIN); C.WOUT = (bf16_t*)(ws + WS_WOUT); C.WUP = (bf16_t*)(ws + WS_WUP); C.WDN = (bf16_t*)(ws + WS_WDN);
    C.XR = (float*)(ws + WS_XR); C.QKV = (bf16_t*)(ws + WS_QKV); C.AO = (bf16_t*)(ws + WS_AO); C.U = (bf16_t*)(ws + WS_U); C.ACT = (bf16_t*)(ws + WS_ACT); C.Z = (bf16_t*)(ws + WS_Z); C.XBC = (bf16_t*)(ws + WS_XBC);
    C.ST = (float*)(ws + WS_ST); C.XT = (bf16_t*)(ws + WS_XT); C.BNCN = (bf16_t*)(ws + WS_BNCN); C.BT = (bf16_t*)(ws + WS_BT); C.XB = (bf16_t*)(ws + WS_XB);
    const int lo = a.ph_lo, hi = a.ph_hi;
#define IN(k) (lo <= (k) && (k) < hi)
#define SEAM(k) do { if (IN(k) && IN((k) + 1)) { cg::this_grid().sync(); } } while (0)
    if (IN(0)) { phase_prologue(C); } SEAM(0);
    if (IN(1)) { pg8::EpiScale<0> E{C.PART, C.QKV, NQKV, nullptr, nullptr}; run_gemm(C, C.XB, C.WQKV, NQKV, DM, E); } SEAM(1);
    if (IN(2)) { phase_attention(C); } SEAM(2);
    if (IN(3)) { pg8::EpiResid E{C.in[I_XP], C.in[I_XS], C.XR, C.XB, C.PART}; run_gemm(C, C.AO, C.WO, DM, DM, E); } SEAM(3);
    if (IN(4)) { pg8::EpiScale<0> E{C.PART, C.U, NUP, nullptr, nullptr}; run_gemm(C, C.XB, C.WUP, NUP, DM, E); } SEAM(4);
    if (IN(5)) { phase_ffn_act(C, 0); } SEAM(5);
    if (IN(6)) { pg8::EpiResid E{C.XR, nullptr, C.XR, C.XB, C.PART}; run_gemm(C, C.ACT, C.WDN, DM, DFF, E); } SEAM(6);
    if (IN(7)) { pg8::EpiScale<2> E{C.PART, C.Z, DIN, C.XBC, C.DTRAW}; run_gemm(C, C.XB, C.WIN, NINP, DM, E); } SEAM(7);
    if (IN(8)) { phase_ssm_conv(C); } SEAM(8);
    if (IN(9)) { phase_ssd_states(C); } SEAM(9);
    if (IN(10)) { phase_ssd_scan(C); } SEAM(10);
    if (IN(11)) { phase_ssd_out(C); } SEAM(11);
    if (IN(12)) { pg8::EpiResid E{C.XR, nullptr, C.XR, C.XB, C.PART}; run_gemm(C, C.Z, C.WOUT, DM, DIN, E); } SEAM(12);
    if (IN(13)) { pg8::EpiScale<0> E{C.PART, C.U, NUP, nullptr, nullptr}; run_gemm(C, C.XB, C.WUP + (size_t)NUP * DM, NUP, DM, E); } SEAM(13);
    if (IN(14)) { phase_ffn_act(C, 1); } SEAM(14);
    if (IN(15)) { pg8::EpiResid E{C.XR, nullptr, C.XR, C.XB, C.PART}; run_gemm(C, C.ACT, C.WDN + (size_t)DM * DFF, DM, DFF, E); } SEAM(15);
    if (IN(16)) { phase_final_norm(C); }
#undef IN
#undef SEAM
}

extern "C" void kernel_launch(void* const* d_in, const int* in_sizes, int n_in, void* d_out, int out_size, void* d_ws, size_t ws_size, hipStream_t stream) {
    static int grid = 0;
    if (grid == 0) {
        if (n_in != 26 || (size_t)out_size != O_END || ws_size < WS_END) { fprintf(stderr, "kernel_launch: unexpected problem: n_in %d out %d ws %zu (need %zu)\n", n_in, out_size, ws_size, (size_t)WS_END); grid = -1; return; }
        int dev = 0, cus = 0, per_cu = 0;
        if (hipGetDevice(&dev) != hipSuccess || hipDeviceGetAttribute(&cus, hipDeviceAttributeMultiprocessorCount, dev) != hipSuccess) { grid = -1; return; }
        if (hipFuncSetAttribute((const void*)hybrid_fwd, hipFuncAttributeMaxDynamicSharedMemorySize, LDS_BYTES) != hipSuccess) { fprintf(stderr, "kernel_launch: hipFuncSetAttribute failed\n"); grid = -1; return; }
        if (hipOccupancyMaxActiveBlocksPerMultiprocessor(&per_cu, (const void*)hybrid_fwd, NTHREADS, LDS_BYTES) != hipSuccess || per_cu < 1) { fprintf(stderr, "kernel_launch: occupancy query says %d\n", per_cu); per_cu = 1; (void)hipGetLastError(); }
        grid = cus * (per_cu > 1 ? 1 : per_cu);
    }
    if (grid < 0) return;
    Args a{};
    for (int i = 0; i < 26; ++i) a.in[i] = (const float*)d_in[i];
    a.out = (float*)d_out; a.ws = (unsigned char*)d_ws;
#if MK_ONE_LAUNCH
    a.ph_lo = 0; a.ph_hi = N_PHASES; a.coop = 1;
    void* args[] = {&a};
    hipError_t e = hipLaunchCooperativeKernel((const void*)hybrid_fwd, dim3(grid), dim3(NTHREADS), args, LDS_BYTES, stream);
    if (e != hipSuccess) fprintf(stderr, "kernel_launch: cooperative launch failed: %s (grid %d)\n", hipGetErrorString(e), grid);
#else
    for (int p = 0; p < N_PHASES; ++p) {
        a.ph_lo = p; a.ph_hi = p + 1; a.coop = 0;
        hipLaunchKernelGGL(hybrid_fwd, dim3(grid), dim3(NTHREADS), LDS_BYTES, stream, a);
    }
#endif
}
```

```cpp
#include <hip/hip_runtime.h>
#include <hip/hip_cooperative_groups.h>
#include <cstdio>
#include <cstdint>
namespace cg = cooperative_groups;

#define LAS __attribute__((address_space(3)))
typedef unsigned short bf16_t;
typedef short bf16x8 __attribute__((ext_vector_type(8)));
typedef short s16x4 __attribute__((ext_vector_type(4)));
typedef float f32x4 __attribute__((ext_vector_type(4)));
typedef float f32x2 __attribute__((ext_vector_type(2)));
typedef float f32x16 __attribute__((ext_vector_type(16)));
typedef unsigned u32x4 __attribute__((ext_vector_type(4)));
typedef unsigned u32x2 __attribute__((ext_vector_type(2)));
typedef __bf16 bf16x2_t __attribute__((ext_vector_type(2)));

constexpr int DM = 1024, NBATCH = 4, SEQ = 4096, MP = NBATCH * SEQ, SBATCH = 128, SLEN = 4, MS = SBATCH * SLEN, MT = MP + MS;
constexpr int NQKV = 1536, DFF = 2816, NUP = 2 * DFF, DIN = 2048, NCONV = 4096, NIN = 6176, NINP = 6400, NSH = 32, NSG = 8, DSTATE = 128;
constexpr int NCHUNK = SEQ / 128;
constexpr float RMS_EPS = 1e-6f;
constexpr float LOG2E = 1.4426950408889634f;

constexpr size_t MiB = 1u << 20;
constexpr size_t WS_CTL = 0;
constexpr size_t WS_PART = 1 * MiB;
constexpr size_t WS_BIASD = 3 * MiB;
constexpr size_t WS_CDEC = 3 * MiB + 65536;
constexpr size_t WS_DTRAW = 4 * MiB;
constexpr size_t WS_WQKV = 12 * MiB, WS_WO = 15 * MiB, WS_WIN = 17 * MiB, WS_WOUT = 30 * MiB, WS_WUP = 34 * MiB  , WS_WDN = 56 * MiB  ;
constexpr size_t WS_XB = 67 * MiB;
constexpr size_t WS_OV = 133 * MiB;
constexpr size_t WS_QKV = WS_OV, WS_AO = WS_OV + 50 * MiB;
constexpr size_t WS_U0 = WS_OV, WS_UL = WS_OV + 3 * MiB, WS_ACT = WS_OV + 182 * MiB;
constexpr size_t WS_Z = WS_OV, WS_XBC = WS_OV + 66 * MiB;
constexpr size_t WS_ST = WS_OV + 198 * MiB, WS_HP = WS_ST;
constexpr size_t WS_XC = WS_OV + 262 * MiB;
constexpr size_t WS_END = WS_OV + 361 * MiB;
static_assert(WS_WQKV + (size_t)NQKV * DM * 2 <= WS_WO && WS_WO + (size_t)DM * DM * 2 <= WS_WIN && WS_WIN + (size_t)NINP * DM * 2 <= WS_WOUT && WS_WOUT + (size_t)DM * DIN * 2 <= WS_WUP &&
              WS_WUP + 2 * (size_t)NUP * DM * 2 <= WS_WDN && WS_WDN + 2 * (size_t)DM * DFF * 2 <= WS_XB && WS_XB + (size_t)MT * DM * 2 <= WS_OV, "weights map");
static_assert(WS_QKV + (size_t)MT * NQKV * 2 <= WS_AO && WS_AO + (size_t)MT * DM * 2 <= WS_END && WS_UL + (size_t)66 * 2 * NUP * 4 <= WS_ACT && WS_U0 + (size_t)66 * 2 * NUP * 4 <= WS_UL && WS_ACT + (size_t)MT * DFF * 2 <= WS_END &&
              WS_Z + (size_t)MT * DIN * 2 <= WS_XBC && WS_XBC + (size_t)MT * NCONV * 2 <= WS_ST && WS_ST + (size_t)MP * DIN * 2 <= WS_XC && WS_XC + (size_t)MP * 3072 * 2 <= WS_END &&
              WS_PART + (size_t)MT * 64 <= WS_BIASD && WS_DTRAW + (size_t)MT * 128 <= WS_WQKV, "overlay map");

constexpr size_t O_YP = 0, O_YS = O_YP + (size_t)MP * DM, O_PK = O_YS + (size_t)MS * DM, O_PV = O_PK + 4 * 128 * 256, O_PCONV = O_PV + 4 * 128 * 256, O_PSSM = O_PCONV + 4 * 3 * NCONV,
                 O_PFFN = O_PSSM + (size_t)4 * 32 * 64 * 128, O_SK = O_PFFN + 2 * 4 * 2 * NUP, O_SV = O_SK + (size_t)128 * 128 * 256, O_SCONV = O_SV + (size_t)128 * 128 * 256,
                 O_SSSM = O_SCONV + (size_t)128 * 3 * NCONV, O_SFFN = O_SSSM + (size_t)128 * 32 * 64 * 128, O_END = O_SFFN + (size_t)2 * 128 * 2 * NUP;

__device__ __forceinline__ float bf2f(unsigned v) { return __uint_as_float(v << 16); }
__device__ __forceinline__ unsigned pk2(float lo, float hi) { f32x2 v = {lo, hi}; bf16x2_t b = __builtin_convertvector(v, bf16x2_t); return __builtin_bit_cast(unsigned, b); }
__device__ __forceinline__ float wave_sum(float v) {
#pragma unroll
    for (int o = 1; o < 64; o <<= 1) v += __shfl_xor(v, o);
    return v;
}
__device__ __forceinline__ float wave_max(float v) {
#pragma unroll
    for (int o = 1; o < 64; o <<= 1) v = fmaxf(v, __shfl_xor(v, o));
    return v;
}
__device__ __forceinline__ float silu_f(float v) { return v * __builtin_amdgcn_rcpf(1.0f + __builtin_amdgcn_exp2f(-LOG2E * v)); }
__device__ __forceinline__ int crow(int r, int hi) { return (r & 3) + 8 * (r >> 2) + 4 * hi; }
__device__ __forceinline__ void unpack8(const u32x4 v, float (&f)[8]) {
    f[0] = bf2f(v.x & 0xffffu); f[1] = bf2f(v.x >> 16); f[2] = bf2f(v.y & 0xffffu); f[3] = bf2f(v.y >> 16);
    f[4] = bf2f(v.z & 0xffffu); f[5] = bf2f(v.z >> 16); f[6] = bf2f(v.w & 0xffffu); f[7] = bf2f(v.w >> 16);
}
__device__ __forceinline__ u32x4 pack8(const float (&f)[8]) { u32x4 o; o.x = pk2(f[0], f[1]); o.y = pk2(f[2], f[3]); o.z = pk2(f[4], f[5]); o.w = pk2(f[6], f[7]); return o; }
__device__ __forceinline__ float row_rstd(const float* part, int row) {
    const f32x4* p = (const f32x4*)(part + (size_t)row * 16);
    const f32x4 a = p[0], b = p[1], c = p[2], d = p[3];
    const float s = ((a.x + a.y) + (a.z + a.w)) + ((b.x + b.y) + (b.z + b.w)) + ((c.x + c.y) + (c.z + c.w)) + ((d.x + d.y) + (d.z + d.w));
    return 1.0f / sqrtf(s * (1.0f / DM) + RMS_EPS);
}
namespace pg8 {
#define PG8_LAS __attribute__((address_space(3)))
typedef unsigned short bf16_t;
typedef short bf16x8 __attribute__((ext_vector_type(8)));
typedef float f32x4 __attribute__((ext_vector_type(4)));
typedef unsigned u32x4 __attribute__((ext_vector_type(4)));
constexpr int BM = 256, BK = 64, HALF = 128, HTB = HALF * BK * 2  , STAGE_BYTES = 8 * HTB, NXCD = 8, WGM = 8;

__host__ __device__ __forceinline__ int lds_byte(int r, int c) { const int st = (r >> 4) * 2 + (c >> 5), rr = r & 15, cc = c & 31, ob = rr * 64 + cc * 2; return st * 1024 + (ob ^ (((ob >> 9) & 1) << 5)); }
__host__ __device__ __forceinline__ void stage_rc(int b, int& R, int& C) { const int st = b / 1024, sb = b % 1024, swz = sb ^ (((sb >> 9) & 1) << 5); R = (st >> 1) * 16 + swz / 64; C = (st & 1) * 32 + (swz % 64) / 2; }
__host__ __device__ __forceinline__ int perm32(int rho) { const int n = rho >> 4, i = rho & 15; return 8 * (i >> 2) + 4 * n + (i & 3); }

struct Unit { int pm, pn, idx; };
struct Gemm { const bf16_t* A; const bf16_t* Bt; int M, N, K; };

struct StaticOrder {
    int nM, nN, nwg, G, c;
    __host__ __device__ __forceinline__ void init(int M, int N, int G_, int c_) { nM = M / BM; nN = N / BM; nwg = nM * nN; G = G_; c = c_; }
    __host__ __device__ __forceinline__ bool next(int i, Unit& u) const {
        const long L = (long)i * G + c; if (L >= nwg) return false;
        int wgid = (int)L; { const int q = nwg / NXCD, r = nwg % NXCD, xcd = wgid % NXCD, off = wgid / NXCD; wgid = (xcd < r ? xcd * (q + 1) : r * (q + 1) + (xcd - r) * q) + off; }
        const int nig = WGM * nN, gid = wgid / nig, fm = gid * WGM, gsz = (nM - fm) < WGM ? (nM - fm) : WGM;
        u.pm = fm + ((wgid % nig) % gsz); u.pn = (wgid % nig) / gsz; u.idx = i; return true;
    }
    __device__ __forceinline__ void a_ready(const Unit&) const {}
    __device__ __forceinline__ void done(const Unit&) const {}
};


template <class Sched> __device__ __forceinline__ void phase_rstd_table(const float* part, const Sched& S, PG8_LAS float* RS) {
    Unit u; const int t = threadIdx.x;
    for (int i = 0; S.next(i, u); ++i) if (t < 256) RS[i * 256 + t] = row_rstd(part, u.pm * BM + t);
    __syncthreads();
}
#define PG8_EPI_BARRIER() do { asm volatile("s_waitcnt lgkmcnt(0)" ::: "memory"); __builtin_amdgcn_s_barrier(); asm volatile("" ::: "memory"); } while (0)
template <int MODE> struct EpiScale {
    static constexpr bool PERM = true, AFTER_DRAIN = false, NEEDS_RSTD = true, WANTS_NEXT = false;
    const float* part; bf16_t* O0; int ldc; bf16_t* O1; float* F; PG8_LAS float* RS;
    __device__ __forceinline__ void operator()(const f32x4 (&acc)[2][2][4][2], const Unit& u, int wr, int wc, int fr, int fq) const {
        const int colt = u.pn * BM; bf16_t* base = O0; int ld = ldc, cl = colt; bool dtile = false;
        if (MODE == 2) { if (colt < 2048) { base = O0; ld = 2048; cl = colt; } else if (colt < 6144) { base = O1; ld = 4096; cl = colt - 2048; } else { dtile = true; } }
        const int row0 = u.pm * BM + wr * 64 + fr, col0 = cl + wc * 32 + 8 * fq;
#pragma unroll
        for (int ai = 0; ai < 2; ++ai)
#pragma unroll
            for (int m = 0; m < 4; ++m) {
                const int row = row0 + ai * HALF + m * 16; const float rs = RS[u.idx * 256 + ai * HALF + wr * 64 + m * 16 + fr];
                if (MODE == 2 && dtile) {
                    if (wc == 0) { float* fp = F + (size_t)row * 32 + 8 * fq; *(f32x4*)fp = acc[ai][0][m][0] * rs; *(f32x4*)(fp + 4) = acc[ai][0][m][1] * rs; }
                } else {
                    bf16_t* rowp = base + (size_t)row * ld + col0;
#pragma unroll
                    for (int bj = 0; bj < 2; ++bj) { const f32x4 v0 = acc[ai][bj][m][0] * rs, v1 = acc[ai][bj][m][1] * rs;
                        u32x4 w; w.x = pk2(v0[0], v0[1]); w.y = pk2(v0[2], v0[3]); w.z = pk2(v1[0], v1[1]); w.w = pk2(v1[2], v1[3]);
                        *(u32x4*)(rowp + bj * HALF) = w; }
                }
            }
    }
};
__device__ __forceinline__ float dpp_ror1(float v) { return __builtin_bit_cast(float, __builtin_amdgcn_update_dpp(0, __builtin_bit_cast(int, v), 0x121, 0xf, 0xf, false)); }
__device__ __forceinline__ float dpp_ror2(float v) { return __builtin_bit_cast(float, __builtin_amdgcn_update_dpp(0, __builtin_bit_cast(int, v), 0x122, 0xf, 0xf, false)); }
__device__ __forceinline__ float dpp_shr1(float old, float v) { return __builtin_bit_cast(float, __builtin_amdgcn_update_dpp(__builtin_bit_cast(int, old), __builtin_bit_cast(int, v), 0x111, 0xf, 0xf, false)); }
__device__ __forceinline__ float dpp_shr2(float old, float v) { return __builtin_bit_cast(float, __builtin_amdgcn_update_dpp(__builtin_bit_cast(int, old), __builtin_bit_cast(int, v), 0x112, 0xf, 0xf, false)); }
struct EpiConvAct {
    static constexpr bool PERM = true, AFTER_DRAIN = false, NEEDS_RSTD = true, WANTS_NEXT = true;
    const float* part; bf16_t* ACT; const float* cw; const float* cb; const float* st; float* U0; float* UL; float* outp; float* outs; PG8_LAS float* X; PG8_LAS float* RS; PG8_LAS float* W;
    __device__ __forceinline__ void operator()(const f32x4 (&acc)[2][2][4][2], const Unit& u, const Unit& nx, bool has_next, int wr, int wc, int fr, int fq) const {
        const int pm = u.pm, pn = u.pn; const bool samp = pm >= MP / BM;
        const int ch0 = pn * 128 + wc * 32 + 8 * fq;
        PG8_LAS float* Wc = W + (u.idx & 1) * 1024; PG8_LAS float* Wn = W + ((u.idx + 1) & 1) * 1024;
        const int tw = wc * 64 + fq * 16 + fr, warr = tw >> 5, wc4 = tw & 31;
        const float* wsrc = ((warr & 3) == 3 ? cb : cw + (warr & 3) * NUP) + ((warr >> 2) ? DFF : 0) + 4 * wc4;
        if (wr == 1 && u.idx == 0) *(PG8_LAS f32x4*)(Wc + 4 * tw) = *(const f32x4*)(wsrc + pn * 128);
        f32x4 wnx = (f32x4){0.f, 0.f, 0.f, 0.f};
        if (wr == 1 && has_next) wnx = *(const f32x4*)(wsrc + nx.pn * 128);
        if (fr >= 14) {
#pragma unroll
            for (int ai = 0; ai < 2; ++ai) { PG8_LAS float* xp = X + ((((ai * 2 + wr) * 4 + wc) * 2 + (fr - 14)) * 4 + fq) * 16;
#pragma unroll
                for (int bj = 0; bj < 2; ++bj)
#pragma unroll
                    for (int n = 0; n < 2; ++n) *(PG8_LAS f32x4*)(xp + bj * 8 + n * 4) = acc[ai][bj][3][n]; }
        }
        PG8_EPI_BARRIER();
        float rs[2][4];
#pragma unroll
        for (int ai = 0; ai < 2; ++ai)
#pragma unroll
            for (int m = 0; m < 4; ++m) rs[ai][m] = RS[u.idx * 256 + ai * HALF + wr * 64 + m * 16 + fr];
        const int sq = fr & 3;
#pragma unroll
        for (int n = 0; n < 2; ++n) {
            const int ch = ch0 + 4 * n;
            const PG8_LAS float* wp = Wc + wc * 32 + 8 * fq + 4 * n;
            const f32x4 wa0 = *(const PG8_LAS f32x4*)wp, wa1 = *(const PG8_LAS f32x4*)(wp + 128), wa2 = *(const PG8_LAS f32x4*)(wp + 256), ba = *(const PG8_LAS f32x4*)(wp + 384);
            const f32x4 wb0 = *(const PG8_LAS f32x4*)(wp + 512), wb1 = *(const PG8_LAS f32x4*)(wp + 640), wb2 = *(const PG8_LAS f32x4*)(wp + 768), bb = *(const PG8_LAS f32x4*)(wp + 896);
#pragma unroll
            for (int ai = 0; ai < 2; ++ai) {
                f32x4 pa = (f32x4){0.f, 0.f, 0.f, 0.f}, pb = pa;
                if (wr == 1 || ai == 1) {
                    const int sai = (wr == 1) ? ai : 0, swr = (wr == 1) ? 0 : 1;
                    const PG8_LAS float* xp = X + ((((sai * 2 + swr) * 4 + wc) * 2 + ((fr == 15) ? 1 : 0)) * 4 + fq) * 16 + n * 4;
                    const float prs = RS[u.idx * 256 + ai * HALF + wr * 64 - ((fr == 15) ? 1 : 2)];
                    pa = *(const PG8_LAS f32x4*)xp * prs; pb = *(const PG8_LAS f32x4*)(xp + 8) * prs;
                }
#pragma unroll
                for (int m = 0; m < 4; ++m) {
                    const int row = pm * BM + ai * HALF + wr * 64 + m * 16 + fr;
                    const f32x4 ca = acc[ai][0][m][n] * rs[ai][m], cv = acc[ai][1][m][n] * rs[ai][m];
                    f32x4 p1a, p2a, p1b, p2b;
#pragma unroll
                    for (int e = 0; e < 4; ++e) {
                        p1a[e] = dpp_shr1(dpp_ror1(pa[e]), ca[e]); p2a[e] = dpp_shr2(dpp_ror2(pa[e]), ca[e]);
                        p1b[e] = dpp_shr1(dpp_ror1(pb[e]), cv[e]); p2b[e] = dpp_shr2(dpp_ror2(pb[e]), cv[e]);
                    }
                    if (samp) {
                        const float* sp = st + (size_t)((row - MP) >> 2) * 2 * NUP + ch;
                        if (sq == 0) { p2a = *(const f32x4*)sp; p2b = *(const f32x4*)(sp + DFF); p1a = *(const f32x4*)(sp + NUP); p1b = *(const f32x4*)(sp + NUP + DFF); }
                        else if (sq == 1) { p2a = *(const f32x4*)(sp + NUP); p2b = *(const f32x4*)(sp + NUP + DFF); }
                    }
                    const f32x4 ya = ba + wa0 * p2a + wa1 * p1a + wa2 * ca, yb = bb + wb0 * p2b + wb1 * p1b + wb2 * cv;
                    const bool first2 = (ai == 0 && wr == 0 && m == 0 && fr < 2), last2 = (ai == 1 && wr == 1 && m == 3 && fr >= 14);
                    if (!(first2 && !samp && (pm & 15) != 0)) {
                        u32x2 ov; ov.x = pk2(silu_f(ya[0]) * yb[0], silu_f(ya[1]) * yb[1]); ov.y = pk2(silu_f(ya[2]) * yb[2], silu_f(ya[3]) * yb[3]);
                        *(u32x2*)(ACT + (size_t)row * DFF + ch) = ov;
                    }
                    if (first2) { float* up = U0 + (size_t)(pm * 2 + fr) * NUP + ch; *(f32x4*)up = ca; *(f32x4*)(up + DFF) = cv; }
                    if (last2) { float* up = UL + (size_t)(pm * 2 + fr - 14) * NUP + ch; *(f32x4*)up = ca; *(f32x4*)(up + DFF) = cv;
                        if (!samp && (pm & 15) == 15) { float* op = outp + (size_t)((pm >> 4) * 2 + fr - 14) * NUP + ch; *(f32x4*)op = ca; *(f32x4*)(op + DFF) = cv; } }
                    if (samp && sq >= 2) { float* op = outs + (size_t)(((row - MP) >> 2) * 2 + sq - 2) * NUP + ch; *(f32x4*)op = ca; *(f32x4*)(op + DFF) = cv; }
                    pa = ca; pb = cv;
                    asm volatile("" ::: "memory");
                }
            }
        }
        if (wr == 1 && has_next) *(PG8_LAS f32x4*)(Wn + 4 * tw) = wnx;
    }
};
struct EpiResid {
    static constexpr bool PERM = true, AFTER_DRAIN = false, NEEDS_RSTD = false, WANTS_NEXT = false;
    bf16_t* XB; float* part;
    __device__ __forceinline__ void operator()(const f32x4 (&acc)[2][2][4][2], const Unit& u, int wr, int wc, int fr, int fq) const {
        const int row0 = u.pm * BM + wr * 64 + fr, col0 = u.pn * BM + wc * 32 + 8 * fq;
#pragma unroll
        for (int ai = 0; ai < 2; ++ai)
#pragma unroll
            for (int m = 0; m < 4; ++m) {
                const int row = row0 + ai * HALF + m * 16;
                float ss = 0.f;
#pragma unroll
                for (int bj = 0; bj < 2; ++bj) { bf16_t* xp = XB + (size_t)row * DM + col0 + bj * HALF;
                    float o[8]; unpack8(*(const u32x4*)xp, o);
                    const f32x4 v0 = (f32x4){o[0], o[1], o[2], o[3]} + acc[ai][bj][m][0], v1 = (f32x4){o[4], o[5], o[6], o[7]} + acc[ai][bj][m][1];
                    ss += (v0[0] * v0[0] + v0[1] * v0[1]) + (v0[2] * v0[2] + v0[3] * v0[3]) + (v1[0] * v1[0] + v1[1] * v1[1]) + (v1[2] * v1[2] + v1[3] * v1[3]);
                    u32x4 w; w.x = pk2(v0[0], v0[1]); w.y = pk2(v0[2], v0[3]); w.z = pk2(v1[0], v1[1]); w.w = pk2(v1[2], v1[3]);
                    *(u32x4*)xp = w; }
                ss += __shfl_xor(ss, 16); ss += __shfl_xor(ss, 32);
                if (fq == 0) part[(size_t)row * 16 + u.pn * 4 + wc] = ss;
            }
    }
};

template <class Epi, class Sched, bool ALIGN_EPI = false, bool SP2 = false>
__device__ __forceinline__ void gemm_phase(PG8_LAS unsigned char* lds, const Gemm g, const Sched& S, const Epi& E) {
    const int tid = threadIdx.x, wid = __builtin_amdgcn_readfirstlane(tid >> 6), lane = tid & 63, wr = wid >> 2, wc = wid & 3, fr = lane & 15, fq = lane >> 4;
    const int K = g.K, nt = K / BK;
    unsigned voffA[2], voffB[2];
#pragma unroll
    for (int i = 0; i < 2; ++i) { int R, C; stage_rc(tid * 16 + i * 8192, R, C); const int Rb = Epi::PERM ? ((R & ~31) + perm32(R & 31)) : R;
        voffA[i] = (unsigned)(R * K + C) * 2u; voffB[i] = (unsigned)(Rb * K + C) * 2u; }
    const size_t kstep = (size_t)(BK * 2);
    const size_t hstep = (size_t)HALF * K * 2;
    const size_t tstep = 2 * hstep;
    const unsigned ldsw = (unsigned)wid * 1024u;
    const int aoff = lds_byte(wr * 64 + fr, fq * 8), boff = lds_byte(wc * 32 + fr, fq * 8);
#define PG8_SA(b, h) (((b) * 2 + (h)) * HTB)
#define PG8_SB(b, h) ((4 + (b) * 2 + (h)) * HTB)
#define PG8_STAGE(bufoff, gbase, voff) do { _Pragma("unroll") for (int _i = 0; _i < 2; ++_i) \
        __builtin_amdgcn_global_load_lds((const unsigned*)((const char*)(gbase) + (voff)[_i]), (PG8_LAS unsigned*)(lds + (bufoff) + ldsw + _i * 8192), 16, 0, 0); } while (0)
#define PG8_LDA(dst, b, h) do { _Pragma("unroll") for (int m = 0; m < 4; ++m) _Pragma("unroll") for (int k = 0; k < 2; ++k) dst[m][k] = *(const PG8_LAS bf16x8*)(lds + PG8_SA(b, h) + aoff + m * 2048 + k * 1024); } while (0)
#define PG8_LDB(dst, b, h) do { _Pragma("unroll") for (int n = 0; n < 2; ++n) _Pragma("unroll") for (int k = 0; k < 2; ++k) dst[n][k] = *(const PG8_LAS bf16x8*)(lds + PG8_SB(b, h) + boff + n * 2048 + k * 1024); } while (0)
#define PG8_MMA(ai, bj, At, Bt) do { __builtin_amdgcn_s_setprio(1); _Pragma("unroll") for (int m = 0; m < 4; ++m) _Pragma("unroll") for (int n = 0; n < 2; ++n) _Pragma("unroll") for (int k = 0; k < 2; ++k) \
        acc[ai][bj][m][n] = __builtin_amdgcn_mfma_f32_16x16x32_bf16(Bt[n][k], At[m][k], acc[ai][bj][m][n], 0, 0, 0); __builtin_amdgcn_s_setprio(0); } while (0)
#define PG8_WAIT_V(n) asm volatile("s_waitcnt vmcnt(" #n ")" ::: "memory")
#define PG8_WAIT_L(n) asm volatile("s_waitcnt lgkmcnt(" #n ")" ::: "memory")
#define PG8_BAR __builtin_amdgcn_s_barrier()
#define PG8_SCHED __builtin_amdgcn_sched_barrier(0)
    Unit cur, nxt; int ui = 0;
    if (!S.next(0, cur)) return;
    f32x4 acc[2][2][4][2];
#pragma unroll
    for (int a = 0; a < 2; ++a)
#pragma unroll
        for (int b = 0; b < 2; ++b)
#pragma unroll
            for (int m = 0; m < 4; ++m)
#pragma unroll
                for (int n = 0; n < 2; ++n) acc[a][b][m][n] = (f32x4){0.f, 0.f, 0.f, 0.f};
    bf16x8 At[4][2], B0[2][2], B1[2][2];
    const char* cA = (const char*)g.A + (size_t)cur.pm * tstep; const char* cB = (const char*)g.Bt + (size_t)cur.pn * tstep;
    S.a_ready(cur);
    if constexpr (SP2) {
        PG8_STAGE(PG8_SB(0, 0), cB, voffB); PG8_STAGE(PG8_SB(0, 1), cB + hstep, voffB); PG8_STAGE(PG8_SA(0, 0), cA, voffA); PG8_STAGE(PG8_SA(0, 1), cA + hstep, voffA);
        if (wr == 1) PG8_BAR;
        PG8_WAIT_V(2); PG8_BAR;
        PG8_STAGE(PG8_SB(1, 0), cB + kstep, voffB); PG8_STAGE(PG8_SA(1, 0), cA + kstep, voffA); PG8_STAGE(PG8_SB(1, 1), cB + hstep + kstep, voffB);
        PG8_WAIT_V(6); PG8_BAR;
    } else {
        PG8_STAGE(PG8_SB(0, 0), cB, voffB); PG8_STAGE(PG8_SA(0, 0), cA, voffA); PG8_STAGE(PG8_SB(0, 1), cB + hstep, voffB); PG8_STAGE(PG8_SA(0, 1), cA + hstep, voffA);
        if (wr == 1) PG8_BAR;
        PG8_WAIT_V(4); PG8_BAR;
        PG8_STAGE(PG8_SB(1, 0), cB + kstep, voffB); PG8_STAGE(PG8_SA(1, 0), cA + kstep, voffA); PG8_STAGE(PG8_SB(1, 1), cB + hstep + kstep, voffB);
        PG8_WAIT_V(6); PG8_BAR;
    }
    for (;;) {
        const bool has_next = S.next(ui + 1, nxt);
        const char* nA = has_next ? (const char*)g.A + (size_t)nxt.pm * tstep : cA; const char* nB = has_next ? (const char*)g.Bt + (size_t)nxt.pn * tstep : cB;
        for (int t = 0; t < nt; t += 2) {
            const bool last = (t == nt - 2);
            const char* a1 = cA + (size_t)(t + 1) * kstep;
            const char* a2 = last ? nA : cA + (size_t)(t + 2) * kstep; const char* b2 = last ? nB : cB + (size_t)(t + 2) * kstep;
            const char* a3 = a2 + kstep; const char* b3 = b2 + kstep;
            if (last && has_next) S.a_ready(nxt);
            if constexpr (SP2) {
            PG8_LDB(B0, 0, 0); PG8_LDB(B1, 0, 1); PG8_SCHED; PG8_LDA(At, 0, 0); PG8_STAGE(PG8_SA(1, 1), a1 + hstep, voffA);
            PG8_WAIT_V(8); PG8_WAIT_L(0); PG8_BAR; PG8_MMA(0, 0, At, B0); PG8_MMA(0, 1, At, B1); PG8_BAR; PG8_SCHED;
            PG8_LDA(At, 0, 1); PG8_STAGE(PG8_SB(0, 0), b2, voffB); PG8_STAGE(PG8_SB(0, 1), b2 + hstep, voffB); PG8_STAGE(PG8_SA(0, 0), a2, voffA);
            PG8_WAIT_V(8); PG8_WAIT_L(0); PG8_BAR; PG8_MMA(1, 0, At, B0); PG8_MMA(1, 1, At, B1); PG8_BAR; PG8_SCHED;
            PG8_LDB(B0, 1, 0); PG8_LDB(B1, 1, 1); PG8_SCHED; PG8_LDA(At, 1, 0); PG8_STAGE(PG8_SA(0, 1), a2 + hstep, voffA);
            PG8_WAIT_V(8); PG8_WAIT_L(0); PG8_BAR; PG8_MMA(0, 0, At, B0); PG8_MMA(0, 1, At, B1); PG8_BAR; PG8_SCHED;
            PG8_LDA(At, 1, 1); PG8_STAGE(PG8_SB(1, 0), b3, voffB); PG8_STAGE(PG8_SB(1, 1), b3 + hstep, voffB); PG8_STAGE(PG8_SA(1, 0), a3, voffA);
            PG8_WAIT_V(8); PG8_WAIT_L(0); PG8_BAR; PG8_MMA(1, 0, At, B0); PG8_MMA(1, 1, At, B1); PG8_BAR; PG8_SCHED;
            } else {
            PG8_LDB(B0, 0, 0); PG8_SCHED; PG8_LDA(At, 0, 0); PG8_STAGE(PG8_SA(1, 1), a1 + hstep, voffA);
            PG8_WAIT_L(8); PG8_BAR; PG8_WAIT_L(0); PG8_MMA(0, 0, At, B0); PG8_BAR; PG8_SCHED;
            PG8_LDB(B1, 0, 1); PG8_STAGE(PG8_SB(0, 0), b2, voffB);
            PG8_BAR; PG8_WAIT_L(0); PG8_MMA(0, 1, At, B1); PG8_BAR;
            PG8_LDA(At, 0, 1); PG8_STAGE(PG8_SA(0, 0), a2, voffA);
            PG8_BAR; PG8_WAIT_L(0); PG8_MMA(1, 0, At, B0); PG8_BAR; PG8_SCHED;
            PG8_STAGE(PG8_SB(0, 1), b2 + hstep, voffB);
            PG8_WAIT_V(6); PG8_BAR; PG8_MMA(1, 1, At, B1); PG8_BAR;
            PG8_LDB(B0, 1, 0); PG8_SCHED; PG8_LDA(At, 1, 0); PG8_STAGE(PG8_SA(0, 1), a2 + hstep, voffA);
            PG8_WAIT_L(8); PG8_BAR; PG8_WAIT_L(0); PG8_MMA(0, 0, At, B0); PG8_BAR; PG8_SCHED;
            PG8_LDB(B1, 1, 1); PG8_STAGE(PG8_SB(1, 0), b3, voffB);
            PG8_BAR; PG8_WAIT_L(0); PG8_MMA(0, 1, At, B1); PG8_BAR;
            PG8_LDA(At, 1, 1); PG8_STAGE(PG8_SA(1, 0), a3, voffA);
            PG8_BAR; PG8_WAIT_L(0); PG8_MMA(1, 0, At, B0); PG8_BAR; PG8_SCHED;
            PG8_STAGE(PG8_SB(1, 1), b3 + hstep, voffB);
            PG8_WAIT_V(6); PG8_BAR; PG8_MMA(1, 1, At, B1); PG8_BAR;
            }
        }
        if constexpr (ALIGN_EPI) { if (wr == 0) PG8_BAR; }
        if constexpr (!Epi::AFTER_DRAIN) { if constexpr (Epi::WANTS_NEXT) E(acc, cur, nxt, has_next, wr, wc, fr, fq); else E(acc, cur, wr, wc, fr, fq); S.done(cur); }
        if (!has_next) break;
#pragma unroll
        for (int a = 0; a < 2; ++a)
#pragma unroll
            for (int b = 0; b < 2; ++b)
#pragma unroll
                for (int m = 0; m < 4; ++m)
#pragma unroll
                    for (int n = 0; n < 2; ++n) acc[a][b][m][n] = (f32x4){0.f, 0.f, 0.f, 0.f};
        cur = nxt; cA = nA; cB = nB; ++ui;
        if constexpr (ALIGN_EPI) { if (wr == 1) PG8_BAR; }
    }
    PG8_WAIT_V(0);
    if constexpr (!ALIGN_EPI) { if (wr == 0) PG8_BAR; }
    PG8_BAR;
    if constexpr (Epi::AFTER_DRAIN) { E.fused(acc, cur, wr, wc, fr, fq, lds, wid, lane); S.done(cur); }
#undef PG8_SA
#undef PG8_SB
#undef PG8_STAGE
#undef PG8_LDA
#undef PG8_LDB
#undef PG8_MMA
#undef PG8_WAIT_V
#undef PG8_WAIT_L
#undef PG8_BAR
#undef PG8_SCHED
}
}

constexpr int NWAVES = 8, NTHREADS = 512;
constexpr int RING_BYTES = 131072, LDS_BYTES = 159744, LDSCTL_OFF = 155648;
struct Args { const float* in[26]; float* out; unsigned char* ws; int ph_lo, ph_hi, coop, pad; };
struct Ctx {
    const float* in[26]; float* out; unsigned char* ws; LAS unsigned char* lds; int tid, lane, wave, G, bid;
    float *PART, *BIASD, *CDEC, *DTRAW, *U0, *UL; bf16_t *WQKV, *WO, *WIN, *WOUT, *WUP, *WDN, *XB, *QKV, *AO, *ACT, *Z, *XBC, *ST, *HP, *XC;
};
enum { I_XP = 0, I_XS, I_CK, I_CV, I_SCONV, I_SSSM, I_SFFN, I_RELB, I_NMIX, I_NFFN, I_NFIN, I_WQKV, I_WO, I_SINK, I_WIN, I_CW, I_CB, I_DTB, I_ALOG, I_SD, I_SNORM, I_WOUT, I_WUP, I_FCW, I_FCB, I_WDN };

__device__ __forceinline__ int t5_bucket(int n) {
    if (n < 16) return n;
    int b = 16;
    b += (n >= 19); b += (n >= 21); b += (n >= 24); b += (n >= 27); b += (n >= 31); b += (n >= 35); b += (n >= 40); b += (n >= 46); b += (n >= 52); b += (n >= 59); b += (n >= 67); b += (n >= 77); b += (n >= 87); b += (n >= 99); b += (n >= 113);
    return b;
}

template <bool UPPERM> __device__ __forceinline__ void p0_transpose_item(const float* W, int K, int N, bf16_t* WT, const float* gain, LAS float* scr, int item, int lane) {
    const int nblk = N / 32, kb = item / nblk, nb = item % nblk, k0 = 64 * kb, n0 = 32 * nb;
    f32x4 ld[8];
#pragma unroll
    for (int i = 0; i < 8; ++i) ld[i] = *(const f32x4*)(W + (size_t)(k0 + 8 * i + (lane >> 3)) * N + n0 + 4 * (lane & 7));
#pragma unroll
    for (int i = 0; i < 8; ++i) { const int kk = 8 * i + (lane >> 3); f32x4 v = ld[i]; if (gain) v = v * gain[k0 + kk];
        LAS float* d = scr + kk * 33 + 4 * (lane & 7); d[0] = v.x; d[1] = v.y; d[2] = v.z; d[3] = v.w; }
    asm volatile("s_waitcnt lgkmcnt(0)" ::: "memory");
    const int c = lane & 7;
#pragma unroll
    for (int j = 0; j < 4; ++j) { const int n = (lane >> 3) + 8 * j; const LAS float* s = scr + (8 * c) * 33 + n;
        u32x4 o; o.x = pk2(s[0 * 33], s[1 * 33]); o.y = pk2(s[2 * 33], s[3 * 33]); o.z = pk2(s[4 * 33], s[5 * 33]); o.w = pk2(s[6 * 33], s[7 * 33]);
        int dr = n0 + n;
        if (UPPERM) dr = (dr < DFF) ? ((dr >> 7) * 256 + (dr & 127)) : (((dr - DFF) >> 7) * 256 + 128 + ((dr - DFF) & 127));
        *(u32x4*)(WT + (size_t)dr * K + k0 + 8 * c) = o; }
    asm volatile("s_waitcnt lgkmcnt(0)" ::: "memory");
}
template <int GRP> __device__ __forceinline__ void convert_group(const Ctx& C, int gw, int NGW) {
    LAS float* scr = (LAS float*)(C.lds + C.wave * 16384);
    constexpr int I0 = (DM / 64) * (NQKV / 32), I1 = (DM / 64) * (DM / 32), I2 = (DM / 64) * (NIN / 32), I3 = (DIN / 64) * (DM / 32), I4 = (DM / 64) * (NUP / 32), I5 = (DFF / 64) * (DM / 32);
    if (GRP == 0) for (int it = gw; it < I0; it += NGW) p0_transpose_item<false>(C.in[I_WQKV], DM, NQKV, C.WQKV, C.in[I_NMIX], scr, it, C.lane);
    if (GRP == 1) for (int it = gw; it < I1 + I4; it += NGW) {
        if (it < I1) p0_transpose_item<false>(C.in[I_WO], DM, DM, C.WO, nullptr, scr, it, C.lane);
        else p0_transpose_item<true>(C.in[I_WUP], DM, NUP, C.WUP, C.in[I_NFFN], scr, it - I1, C.lane); }
    if (GRP == 2) {
        for (int it = gw; it < I5 + I2; it += NGW) {
            if (it < I5) p0_transpose_item<false>(C.in[I_WDN], DFF, DM, C.WDN, nullptr, scr, it, C.lane);
            else p0_transpose_item<false>(C.in[I_WIN], DM, NIN, C.WIN, C.in[I_NMIX] + DM, scr, it - I5, C.lane); }
        u32x4* z = (u32x4*)(C.WIN + (size_t)NIN * DM);
        for (int i = gw * 64 + C.lane; i < (NINP - NIN) * DM / 8; i += NGW * 64) z[i] = (u32x4){0u, 0u, 0u, 0u};
    }
    if (GRP == 3) for (int it = gw; it < I3 + I4; it += NGW) {
        if (it < I3) p0_transpose_item<false>(C.in[I_WOUT], DIN, DM, C.WOUT, C.in[I_SNORM], scr, it, C.lane);
        else p0_transpose_item<true>(C.in[I_WUP] + (size_t)DM * NUP, DM, NUP, C.WUP + (size_t)NUP * DM, C.in[I_NFFN] + DM, scr, it - I3, C.lane); }
    if (GRP == 4) for (int it = gw; it < I5; it += NGW) p0_transpose_item<false>(C.in[I_WDN] + (size_t)DFF * DM, DFF, DM, C.WDN + (size_t)DM * DFF, nullptr, scr, it, C.lane);
}
template <int GRP> __device__ __forceinline__ void convert_in_tail(const Ctx& C, int nwg) {
    const int r = nwg % C.G;
    if (C.bid >= r) convert_group<GRP>(C, (C.bid - r) * NWAVES + C.wave, (C.G - r) * NWAVES);
    __syncthreads();
}
__device__ __forceinline__ void phase_prologue(const Ctx& C) {
    const int gw = C.bid * NWAVES + C.wave, NGW = C.G * NWAVES;
    convert_group<0>(C, gw, NGW);
    for (int m = gw; m < MT; m += NGW) {
        const float* xrow = (m < MP) ? C.in[I_XP] + (size_t)m * DM : C.in[I_XS] + (size_t)(m - MP) * DM;
        const f32x4* xr = (const f32x4*)xrow + 2 * C.lane; f32x4 v[4]; float s = 0.f;
#pragma unroll
        for (int j = 0; j < 4; ++j) { v[j] = xr[128 * (j >> 1) + (j & 1)]; s += (v[j].x * v[j].x + v[j].y * v[j].y) + (v[j].z * v[j].z + v[j].w * v[j].w); }
        s = wave_sum(s);
        u32x4* o16 = (u32x4*)(C.XB + (size_t)m * DM) + C.lane;
#pragma unroll
        for (int j = 0; j < 2; ++j) { u32x4 w; w.x = pk2(v[2 * j].x, v[2 * j].y); w.y = pk2(v[2 * j].z, v[2 * j].w); w.z = pk2(v[2 * j + 1].x, v[2 * j + 1].y); w.w = pk2(v[2 * j + 1].z, v[2 * j + 1].w); o16[64 * j] = w; }
        if (C.lane < 16) C.PART[(size_t)m * 16 + C.lane] = (C.lane == 0) ? s : 0.f;
    }
    { const int gt = C.bid * NTHREADS + C.tid; if (gt < 16 * 128) { const int h = gt >> 7, d = gt & 127; C.BIASD[gt] = C.in[I_RELB][t5_bucket(d) * 16 + h] * LOG2E; } }
}

#define MFMA32(a, b, c) __builtin_amdgcn_mfma_f32_32x32x16_bf16((a), (b), (c), 0, 0, 0)
typedef short v4i16_t __attribute__((ext_vector_type(4)));
__device__ __forceinline__ s16x4 lds_tr4(const LAS bf16_t* p) { return __builtin_bit_cast(s16x4, __builtin_amdgcn_ds_read_tr16_b64_v4i16((LAS v4i16_t*)p)); }
__device__ __forceinline__ bf16x8 cat8(s16x4 a, s16x4 b) { return (bf16x8){a[0], a[1], a[2], a[3], b[0], b[1], b[2], b[3]}; }
__device__ __forceinline__ f32x16 zero16() { f32x16 z; for (int i = 0; i < 16; ++i) z[i] = 0.f; return z; }

__device__ __forceinline__ void attn_prompt_unit(const Ctx& C, int b, int c, int g) {
    LAS bf16_t* Ks = (LAS bf16_t*)C.lds;
    LAS bf16_t* Vt = (LAS bf16_t*)(C.lds + 36864);
    LAS float* Bd = (LAS float*)(C.lds + 36864 + 33792);
    const int tid = C.tid, lane = C.lane, w = C.wave;
    const bf16_t* qbase = C.QKV + (size_t)(b * SEQ + c * 128 + (w & 1) * 64 + (lane & 31)) * NQKV + (g * 4 + (w >> 1)) * 64 + 8 * (lane >> 5);
    bf16x8 qn[4];
#pragma unroll
    for (int s = 0; s < 4; ++s) qn[s] = *(const bf16x8*)(qbase + 16 * s);
#pragma unroll
    for (int i = 0; i < 4; ++i) {
        const int id = i * NTHREADS + tid, row = id >> 3, ch = id & 7, kpos = (c - 1) * 128 + row;
        u32x4 kv = (u32x4){0u, 0u, 0u, 0u}, vv = (u32x4){0u, 0u, 0u, 0u};
        if (kpos >= 0) { const bf16_t* src = C.QKV + (size_t)(b * SEQ + kpos) * NQKV + 1024 + g * 64 + ch * 8; kv = *(const u32x4*)src; vv = *(const u32x4*)(src + 256); }
        *(LAS u32x4*)(Ks + row * 72 + ch * 8) = kv;
        const int prow = (row & ~15) | ((row & 3) + 4 * ((row >> 3) & 1) + 8 * ((row >> 2) & 1));
        LAS bf16_t* vd = Vt + (ch * 8) * 264 + prow;
        vd[0 * 264] = (bf16_t)(vv.x & 0xffffu); vd[1 * 264] = (bf16_t)(vv.x >> 16); vd[2 * 264] = (bf16_t)(vv.y & 0xffffu); vd[3 * 264] = (bf16_t)(vv.y >> 16);
        vd[4 * 264] = (bf16_t)(vv.z & 0xffffu); vd[5 * 264] = (bf16_t)(vv.z >> 16); vd[6 * 264] = (bf16_t)(vv.w & 0xffffu); vd[7 * 264] = (bf16_t)(vv.w >> 16);
    }
    Bd[tid] = C.BIASD[(g * 4 + (tid >> 7)) * 128 + (tid & 127)];
    __syncthreads();
    const int r = w >> 1, ph = w & 1, hh = g * 4 + r, ql = lane & 31, hi = lane >> 5;
    const float sink2 = C.in[I_SINK][hh] * LOG2E;
    const int jmin = (c == 0) ? 128 : 0;
    for (int qg = 0; qg < 2; ++qg) {
        const int q0 = ph * 64 + qg * 32, qi = q0 + ql, t0 = q0 >> 5;
        const size_t qrow = (size_t)(b * SEQ + c * 128 + qi);
        bf16x8 qf[4];
#pragma unroll
        for (int s = 0; s < 4; ++s) qf[s] = qn[s];
        if (qg == 0) {
#pragma unroll
            for (int s = 0; s < 4; ++s) qn[s] = *(const bf16x8*)(qbase + (size_t)32 * NQKV + 16 * s); }
        f32x16 S[5];
#pragma unroll
        for (int kk = 0; kk < 5; ++kk) {
            S[kk] = zero16();
#pragma unroll
            for (int s = 0; s < 4; ++s) { const bf16x8 kf = *(const LAS bf16x8*)(Ks + (32 * (t0 + kk) + ql) * 72 + 16 * s + 8 * hi); S[kk] = MFMA32(kf, qf[s], S[kk]); }
        }
        float mx = sink2; const int dbase = qi + 128 - 32 * t0;
#pragma unroll
        for (int kk = 0; kk < 5; ++kk)
#pragma unroll
            for (int rr = 0; rr < 16; ++rr) {
                const int jl = 32 * kk + crow(rr, hi), d = dbase - jl, j = 32 * t0 + jl;
                float v = S[kk][rr] * (0.125f * LOG2E) + Bd[r * 128 + (d & 127)];
                if (kk == 0 || kk == 4 || c == 0) { const bool ok = (d >= 0) && (d < 128) && (j >= jmin); v = ok ? v : -INFINITY; }
                S[kk][rr] = v; mx = fmaxf(mx, v);
            }
        mx = fmaxf(mx, __shfl_xor(mx, 32));
        float l = 0.f;
#pragma unroll
        for (int kk = 0; kk < 5; ++kk)
#pragma unroll
            for (int rr = 0; rr < 16; ++rr) { const float p = __builtin_amdgcn_exp2f(S[kk][rr] - mx); S[kk][rr] = p; l += p; }
        l += __shfl_xor(l, 32); l += __builtin_amdgcn_exp2f(sink2 - mx);
        const float inv = 1.0f / l;
        f32x16 O[2]; O[0] = zero16(); O[1] = zero16();
#pragma unroll
        for (int kk = 0; kk < 5; ++kk)
#pragma unroll
            for (int ks = 0; ks < 2; ++ks) {
                u32x4 pw; pw.x = pk2(S[kk][8 * ks + 0], S[kk][8 * ks + 1]); pw.y = pk2(S[kk][8 * ks + 2], S[kk][8 * ks + 3]); pw.z = pk2(S[kk][8 * ks + 4], S[kk][8 * ks + 5]); pw.w = pk2(S[kk][8 * ks + 6], S[kk][8 * ks + 7]);
                const bf16x8 pf = __builtin_bit_cast(bf16x8, pw);
#pragma unroll
                for (int dt = 0; dt < 2; ++dt) { const bf16x8 vf = *(const LAS bf16x8*)(Vt + (32 * dt + ql) * 264 + 32 * (t0 + kk) + 16 * ks + 8 * hi); O[dt] = MFMA32(vf, pf, O[dt]); }
            }
#pragma unroll
        for (int dt = 0; dt < 2; ++dt)
#pragma unroll
            for (int q4 = 0; q4 < 4; ++q4) {
                u32x2 wv; wv.x = pk2(O[dt][4 * q4] * inv, O[dt][4 * q4 + 1] * inv); wv.y = pk2(O[dt][4 * q4 + 2] * inv, O[dt][4 * q4 + 3] * inv);
                *(u32x2*)(C.AO + qrow * DM + hh * 64 + 32 * dt + 8 * q4 + 4 * hi) = wv;
            }
    }
    if (c == NCHUNK - 1) {
#pragma unroll
        for (int i = 0; i < 2; ++i) {
            const int id = i * NTHREADS + tid, wq = id >> 3, ch = id & 7;
            const bf16_t* src = C.QKV + (size_t)(b * SEQ + SEQ - 128 + wq) * NQKV + 1024 + g * 64 + ch * 8;
            float kf[8], vf[8]; unpack8(*(const u32x4*)src, kf); unpack8(*(const u32x4*)(src + 256), vf);
            float* ok = C.out + O_PK + ((size_t)(b * 128 + wq) * 4 + g) * 64 + ch * 8; float* ov = C.out + O_PV + ((size_t)(b * 128 + wq) * 4 + g) * 64 + ch * 8;
            *(f32x4*)ok = (f32x4){kf[0], kf[1], kf[2], kf[3]}; *(f32x4*)(ok + 4) = (f32x4){kf[4], kf[5], kf[6], kf[7]};
            *(f32x4*)ov = (f32x4){vf[0], vf[1], vf[2], vf[3]}; *(f32x4*)(ov + 4) = (f32x4){vf[4], vf[5], vf[6], vf[7]};
        }
    }
    __syncthreads();
}
__device__ __forceinline__ void attn_sample_unit(const Ctx& C, int b, int g) {
    constexpr int KP = 68;
    LAS float* Kc = (LAS float*)C.lds;
    LAS float* Vc = Kc + 132 * KP;
    LAS float* Qs = Vc + 132 * KP;
    LAS float* Ps = Qs + 16 * KP;
    LAS float* Bd2 = Ps + 16 * 132;
    LAS float* Po = Bd2 + 512;
    const int tid = C.tid, lane = C.lane, w = C.wave;
    const float* ck = C.in[I_CK]; const float* cv = C.in[I_CV];
#pragma unroll
    for (int i = 0; i < 4; ++i) {
        const int id = i * NTHREADS + tid, wq = id >> 4, ch = id & 15; const size_t off = ((size_t)(b * 128 + wq) * 4 + g) * 64 + ch * 4;
        const f32x4 kv = *(const f32x4*)(ck + off), vv = *(const f32x4*)(cv + off);
        *(LAS f32x4*)(Kc + wq * KP + ch * 4) = kv; *(LAS f32x4*)(Vc + wq * KP + ch * 4) = vv;
        if (wq >= 4) { const size_t oo = ((size_t)(b * 128 + wq - 4) * 4 + g) * 64 + ch * 4; *(f32x4*)(C.out + O_SK + oo) = kv; *(f32x4*)(C.out + O_SV + oo) = vv; }
    }
    { const int isv = tid >> 8, s = (tid >> 6) & 3, d = tid & 63;
      const float val = bf2f(C.QKV[(size_t)(MP + b * 4 + s) * NQKV + 1024 + isv * 256 + g * 64 + d]);
      (isv ? Vc : Kc)[(128 + s) * KP + d] = val;
      C.out[(isv ? O_SV : O_SK) + ((size_t)(b * 128 + 124 + s) * 4 + g) * 64 + d] = val; }
#pragma unroll
    for (int i = 0; i < 2; ++i) { const int id = i * NTHREADS + tid, qr = id >> 6, d = id & 63, r = qr >> 2, s = qr & 3;
        Qs[qr * KP + d] = bf2f(C.QKV[(size_t)(MP + b * 4 + s) * NQKV + (g * 4 + r) * 64 + d]); }
    Bd2[tid] = C.BIASD[(g * 4 + (tid >> 7)) * 128 + (tid & 127)];
    __syncthreads();
    for (int kb = 0; kb < 132; kb += 128) {
        const int key = kb + (tid >> 2), r = tid & 3;
        if (key < 132) {
            f32x4 acc = (f32x4){0.f, 0.f, 0.f, 0.f};
#pragma unroll 4
            for (int d4 = 0; d4 < 16; ++d4) {
                const f32x4 k4 = *(const LAS f32x4*)(Kc + key * KP + 4 * d4);
#pragma unroll
                for (int s = 0; s < 4; ++s) { const f32x4 q4 = *(const LAS f32x4*)(Qs + (r * 4 + s) * KP + 4 * d4); acc[s] += (k4.x * q4.x + k4.y * q4.y) + (k4.z * q4.z + k4.w * q4.w); }
            }
#pragma unroll
            for (int s = 0; s < 4; ++s) { const int dist = 128 + s - key; const bool ok = (dist >= 0) && (dist < 128);
                Ps[(r * 4 + s) * 132 + key] = ok ? acc[s] * (0.125f * LOG2E) + Bd2[r * 128 + (dist & 127)] : -INFINITY; }
        }
    }
    __syncthreads();
#pragma unroll
    for (int qq = 0; qq < 2; ++qq) {
        const int qr = 2 * w + qq, r = qr >> 2; const float sink2 = C.in[I_SINK][g * 4 + r] * LOG2E;
        LAS float* pr = Ps + qr * 132;
        const float v0 = pr[lane], v1 = pr[64 + lane], v2 = (lane < 4) ? pr[128 + lane] : -INFINITY;
        const float mx = fmaxf(wave_max(fmaxf(fmaxf(v0, v1), v2)), sink2);
        const float p0 = __builtin_amdgcn_exp2f(v0 - mx), p1 = __builtin_amdgcn_exp2f(v1 - mx), p2 = __builtin_amdgcn_exp2f(v2 - mx);
        const float l = wave_sum(p0 + p1 + p2) + __builtin_amdgcn_exp2f(sink2 - mx), inv = 1.0f / l;
        pr[lane] = p0 * inv; pr[64 + lane] = p1 * inv; if (lane < 4) pr[128 + lane] = p2 * inv;
    }
    __syncthreads();
    { const int kg = tid >> 7, q2 = (tid >> 4) & 7, dq = tid & 15; f32x4 o0 = (f32x4){0.f, 0.f, 0.f, 0.f}, o1 = o0;
      const LAS float* pa = Ps + (2 * q2) * 132 + kg * 33; const LAS float* vp = Vc + (kg * 33) * KP + 4 * dq;
#pragma unroll 3
      for (int k = 0; k < 33; ++k) { const f32x4 v4 = *(const LAS f32x4*)(vp + k * KP); const float pA = pa[k], pB = pa[132 + k]; o0 += v4 * pA; o1 += v4 * pB; }
      *(LAS f32x4*)(Po + ((kg * 16 + 2 * q2) * 64) + 4 * dq) = o0; *(LAS f32x4*)(Po + ((kg * 16 + 2 * q2 + 1) * 64) + 4 * dq) = o1; }
    __syncthreads();
    { const int qr = tid >> 5, d = (tid & 31) * 2, r = qr >> 2, s = qr & 3; const LAS float* pp = Po + qr * 64 + d;
      const float o0 = (pp[0] + pp[1024]) + (pp[2048] + pp[3072]), o1 = (pp[1] + pp[1025]) + (pp[2049] + pp[3073]);
      *(unsigned*)(C.AO + (size_t)(MP + b * 4 + s) * DM + (g * 4 + r) * 64 + d) = pk2(o0, o1); }
    __syncthreads();
}
__device__ __forceinline__ void phase_attention(const Ctx& C) {
    for (int u = C.bid; u < 1024; u += C.G) {
        if (u < 512) attn_prompt_unit(C, u >> 7, (u >> 2) & 31, u & 3);
        else attn_sample_unit(C, (u - 512) >> 2, u & 3);
    }
}

__device__ __forceinline__ void ffn_fixup_tile(const Ctx& C, int layer, int pm) {
    if ((pm & 15) != 0 && pm < MP / 256) {
        const float* cw = C.in[I_FCW] + (size_t)layer * 3 * NUP; const float* cb = C.in[I_FCB] + (size_t)layer * NUP;
        int t_ = (int)threadIdx.x; asm volatile("" : "+v"(t_));
        for (int id = t_; id < 2 * (DFF / 4); id += NTHREADS) {
            const int k = (id >= DFF / 4) ? 1 : 0, ch = 4 * (id - k * (DFF / 4));
            const float* u0 = C.U0 + (size_t)(pm * 2) * NUP + ch; const float* ul = C.UL + (size_t)((pm - 1) * 2) * NUP + ch;
            const f32x4 ca = *(const f32x4*)(u0 + k * NUP), cv = *(const f32x4*)(u0 + k * NUP + DFF);
            const f32x4 p1a = k ? *(const f32x4*)u0 : *(const f32x4*)(ul + NUP), p1b = k ? *(const f32x4*)(u0 + DFF) : *(const f32x4*)(ul + NUP + DFF);
            const f32x4 p2a = k ? *(const f32x4*)(ul + NUP) : *(const f32x4*)ul, p2b = k ? *(const f32x4*)(ul + NUP + DFF) : *(const f32x4*)(ul + DFF);
            const f32x4 ya = *(const f32x4*)(cb + ch) + *(const f32x4*)(cw + ch) * p2a + *(const f32x4*)(cw + NUP + ch) * p1a + *(const f32x4*)(cw + 2 * NUP + ch) * ca;
            const f32x4 yb = *(const f32x4*)(cb + DFF + ch) + *(const f32x4*)(cw + DFF + ch) * p2b + *(const f32x4*)(cw + NUP + DFF + ch) * p1b + *(const f32x4*)(cw + 2 * NUP + DFF + ch) * cv;
            u32x2 ov; ov.x = pk2(silu_f(ya[0]) * yb[0], silu_f(ya[1]) * yb[1]); ov.y = pk2(silu_f(ya[2]) * yb[2], silu_f(ya[3]) * yb[3]);
            *(u32x2*)(C.ACT + (size_t)(pm * 256 + k) * DFF + ch) = ov;
        }
    }
    asm volatile("s_waitcnt vmcnt(0)" ::: "memory");
    __syncthreads();
}

__device__ __forceinline__ void phase_final_norm(const Ctx& C) {
    const int gw = C.bid * NWAVES + C.wave, NGW = C.G * NWAVES; const f32x4* gp = (const f32x4*)C.in[I_NFIN] + 2 * C.lane;
    f32x4 gv[4];
#pragma unroll
    for (int j = 0; j < 4; ++j) gv[j] = gp[128 * (j >> 1) + (j & 1)];
    for (int m = gw; m < MT; m += NGW) {
        const float rs = row_rstd(C.PART, m);
        const u32x4* xr = (const u32x4*)(C.XB + (size_t)m * DM) + C.lane;
        f32x4* o = (f32x4*)(C.out + (m < MP ? O_YP + (size_t)m * DM : O_YS + (size_t)(m - MP) * DM)) + 2 * C.lane;
#pragma unroll
        for (int j = 0; j < 2; ++j) { float f[8]; unpack8(xr[64 * j], f);
            o[128 * j] = (f32x4){f[0], f[1], f[2], f[3]} * rs * gv[2 * j]; o[128 * j + 1] = (f32x4){f[4], f[5], f[6], f[7]} * rs * gv[2 * j + 1]; }
    }
}

__device__ __forceinline__ float softplus_f(float x) { return (x > 20.f) ? x : log1pf(__expf(x)); }
template <int NCH> struct ConvRaw { u32x4 h[3]; u32x4 raw[128 * NCH / NTHREADS]; };
template <int NCH> __device__ __forceinline__ void conv_load(const Ctx& C, size_t row0, int t0, int c0, ConvRaw<NCH>& R) {
    constexpr int H = 128 * NCH / NTHREADS;
    int tl = C.tid; asm volatile("" : "+v"(tl));
    const int ch = tl % NCH, r0 = (tl / NCH) * H, cc = c0 + ch * 8;
    const bf16_t* src = C.XBC + (row0 + r0) * NCONV + cc;
    if (t0 + r0 >= 3) { R.h[0] = *(const u32x4*)(src - 3 * NCONV); R.h[1] = *(const u32x4*)(src - 2 * NCONV); R.h[2] = *(const u32x4*)(src - NCONV); }
    else { R.h[0] = (u32x4){0u, 0u, 0u, 0u}; R.h[1] = R.h[0]; R.h[2] = R.h[0]; }
#pragma unroll
    for (int i = 0; i < H; ++i) R.raw[i] = *(const u32x4*)(src + (size_t)i * NCONV);
}
template <int NCH> __device__ __forceinline__ void conv_compute(const Ctx& C, int c0, const ConvRaw<NCH>& R, u32x4 (&outv)[128 * NCH / NTHREADS], float* state) {
    constexpr int H = 128 * NCH / NTHREADS;
    int tl = C.tid; asm volatile("" : "+v"(tl));
    const int ch = tl % NCH, r0 = (tl / NCH) * H, cc = c0 + ch * 8;
    const float* cw = C.in[I_CW] + cc; const float* cb = C.in[I_CB] + cc;
    float w[4][8], bv[8];
#pragma unroll
    for (int k = 0; k < 4; ++k) { const f32x4 a = *(const f32x4*)(cw + k * NCONV), b = *(const f32x4*)(cw + k * NCONV + 4); w[k][0] = a.x; w[k][1] = a.y; w[k][2] = a.z; w[k][3] = a.w; w[k][4] = b.x; w[k][5] = b.y; w[k][6] = b.z; w[k][7] = b.w; }
    { const f32x4 a = *(const f32x4*)cb, b = *(const f32x4*)(cb + 4); bv[0] = a.x; bv[1] = a.y; bv[2] = a.z; bv[3] = a.w; bv[4] = b.x; bv[5] = b.y; bv[6] = b.z; bv[7] = b.w; }
    float a3[8], a2[8], a1[8]; unpack8(R.h[0], a3); unpack8(R.h[1], a2); unpack8(R.h[2], a1);
#pragma unroll
    for (int i = 0; i < H; ++i) {
        float cur[8], o[8]; unpack8(R.raw[i], cur);
#pragma unroll
        for (int e = 0; e < 8; ++e) o[e] = silu_f(bv[e] + w[0][e] * a3[e] + w[1][e] * a2[e] + w[2][e] * a1[e] + w[3][e] * cur[e]);
        outv[i] = pack8(o);
        if (state != nullptr && r0 + i >= 125) { float* op = state + (size_t)(r0 + i - 125) * NCONV + cc; *(f32x4*)op = (f32x4){cur[0], cur[1], cur[2], cur[3]}; *(f32x4*)(op + 4) = (f32x4){cur[4], cur[5], cur[6], cur[7]}; }
#pragma unroll
        for (int e = 0; e < 8; ++e) { a3[e] = a2[e]; a2[e] = a1[e]; a1[e] = cur[e]; }
    }
}
template <int NCH> __device__ __forceinline__ void conv_rows(const Ctx& C, size_t row0, int t0, int c0, u32x4 (&outv)[128 * NCH / NTHREADS], float* state) {
    ConvRaw<NCH> R; conv_load<NCH>(C, row0, t0, c0, R); conv_compute<NCH>(C, c0, R, outv, state);
}
__device__ __forceinline__ void chunk_scan_v(float r0, float r1, float dtb, float A, int lane, float& cs0, float& cs1, float& d0, float& d1, float& tot);
__device__ __forceinline__ void chunk_scan(const float* dtp  , float dtb, float A, int lane, float& cs0, float& cs1, float& d0, float& d1, float& tot) {
    chunk_scan_v(dtp[(size_t)(2 * lane) * 32], dtp[(size_t)(2 * lane + 1) * 32], dtb, A, lane, cs0, cs1, d0, d1, tot);
}
__device__ __forceinline__ void chunk_scan_v(float r0, float r1, float dtb, float A, int lane, float& cs0, float& cs1, float& d0, float& d1, float& tot) {
    d0 = softplus_f(r0 + dtb); d1 = softplus_f(r1 + dtb);
    const float a0 = d0 * A, a1 = d1 * A; float inc = a0 + a1;
#pragma unroll
    for (int o = 1; o < 64; o <<= 1) { const float v = __shfl_up(inc, o); if (lane >= o) inc += v; }
    cs1 = inc; cs0 = inc - a1; tot = __shfl(inc, 63);
}
constexpr int XP = 272, BP = 144;
__device__ __forceinline__ void ssd_states_unit(const Ctx& C, int rb, int g) {
    const int w = C.wave, lane = C.lane, r = w >> 1, phalf = w & 1, h = g * 4 + r, ql = lane & 31, hi = lane >> 5, li = lane & 15, gi = (lane >> 4) & 1;
    LAS bf16_t* Xn = (LAS bf16_t*)C.lds;
    LAS bf16_t* Bn = (LAS bf16_t*)(C.lds + 128 * XP * 2);
    LAS float* F = (LAS float*)(C.lds + 128 * XP * 2 + 128 * BP * 2) + w * 128;
    const size_t row0 = (size_t)rb * 128;
    {   const int t0 = (rb & 31) * 128; float* sto = ((rb & 31) == 31) ? C.out + O_PCONV + (size_t)(rb >> 5) * 3 * NCONV : nullptr;
        u32x4 xv[8]; conv_rows<32>(C, row0, t0, g * 256, xv, sto);
        { const int ch = C.tid & 31, r0 = (C.tid >> 5) * 8;
#pragma unroll
          for (int i = 0; i < 8; ++i) { *(LAS u32x4*)(Xn + (r0 + i) * XP + ch * 8) = xv[i]; *(u32x4*)(C.XC + (row0 + r0 + i) * 3072 + g * 256 + ch * 8) = xv[i]; } }
        u32x4 bvv[4]; conv_rows<16>(C, row0, t0, 2048 + g * 128, bvv, sto);
        { const int ch = C.tid & 15, r0 = (C.tid >> 4) * 4;
#pragma unroll
          for (int i = 0; i < 4; ++i) { *(LAS u32x4*)(Bn + (r0 + i) * BP + ch * 8) = bvv[i]; *(u32x4*)(C.XC + (row0 + r0 + i) * 3072 + 2048 + g * 128 + ch * 8) = bvv[i]; } } }
    const float A = -__expf(C.in[I_ALOG][h]);
    float cs0, cs1, d0, d1, tot; chunk_scan(C.DTRAW + (size_t)(rb * 128) * 32 + h, C.in[I_DTB][h], A, lane, cs0, cs1, d0, d1, tot);
    F[2 * lane] = __expf(tot - cs0) * d0; F[2 * lane + 1] = __expf(tot - cs1) * d1;
    if (phalf == 0 && lane == 0) C.CDEC[rb * 32 + h] = __expf(tot);
    __syncthreads();
    f32x16 acc[4];
#pragma unroll
    for (int nt = 0; nt < 4; ++nt) acc[nt] = zero16();
    const LAS bf16_t* xb = Xn + (8 * hi + (li >> 2)) * XP + r * 64 + phalf * 32 + 16 * gi + 4 * (li & 3);
    const LAS bf16_t* bb = Bn + (8 * hi + (li >> 2)) * BP + 16 * gi + 4 * (li & 3);
#pragma unroll
    for (int s = 0; s < 8; ++s) {
        const s16x4 x0 = lds_tr4(xb + 16 * s * XP), x1 = lds_tr4(xb + (16 * s + 4) * XP);
        const f32x4 f0 = *(const LAS f32x4*)(F + 16 * s + 8 * hi), f1 = *(const LAS f32x4*)(F + 16 * s + 8 * hi + 4);
        u32x4 aw; aw.x = pk2(bf2f((unsigned short)x0[0]) * f0.x, bf2f((unsigned short)x0[1]) * f0.y); aw.y = pk2(bf2f((unsigned short)x0[2]) * f0.z, bf2f((unsigned short)x0[3]) * f0.w);
        aw.z = pk2(bf2f((unsigned short)x1[0]) * f1.x, bf2f((unsigned short)x1[1]) * f1.y); aw.w = pk2(bf2f((unsigned short)x1[2]) * f1.z, bf2f((unsigned short)x1[3]) * f1.w);
        const bf16x8 af = __builtin_bit_cast(bf16x8, aw);
#pragma unroll
        for (int nt = 0; nt < 4; ++nt) { const bf16x8 bfr = cat8(lds_tr4(bb + 16 * s * BP + nt * 32), lds_tr4(bb + (16 * s + 4) * BP + nt * 32)); acc[nt] = MFMA32(af, bfr, acc[nt]); }
    }
    bf16_t* stp = C.ST + ((size_t)(rb * 32 + h) * 64 + phalf * 32) * 128 + ql;
#pragma unroll
    for (int nt = 0; nt < 4; ++nt)
#pragma unroll
        for (int rg = 0; rg < 16; ++rg) stp[(size_t)crow(rg, hi) * 128 + nt * 32] = (bf16_t)(pk2(acc[nt][rg], 0.f) & 0xffffu);
    __syncthreads();
}
__device__ __forceinline__ void ssd_sample_unit(const Ctx& C, int b, int g) {
    LAS float* Bs = (LAS float*)C.lds;
    LAS float* Cs = Bs + 512;
    LAS float* Xs = Cs + 512;
    LAS float* Dts = Xs + 1024;
    LAS float* Css = Dts + 16;
    LAS float* Cbm = Css + 16;
    LAS float* Yt = Cbm + 16;
    LAS float* Red = Yt + 1024;
    const int tid = C.tid, lane = C.lane, w = C.wave; const size_t m0 = (size_t)MP + b * 4;
    const int p = tid >> 3, ns = tid & 7;
    f32x4 hv[4][4];
#pragma unroll
    for (int hl = 0; hl < 4; ++hl) { const float* sin = C.in[I_SSSM] + ((size_t)(b * 32 + g * 4 + hl) * 64 + p) * 128 + ns * 4;
#pragma unroll
        for (int k = 0; k < 4; ++k) hv[hl][k] = __builtin_nontemporal_load((const f32x4*)(sin + 32 * k)); }
    __syncthreads();
    if (tid < 64) {
        const int cc = (tid < 32) ? g * 256 + 8 * tid : (tid < 48) ? 2048 + g * 128 + 8 * (tid - 32) : 3072 + g * 128 + 8 * (tid - 48);
        const float* stp = C.in[I_SCONV] + (size_t)b * 3 * NCONV + cc; const bf16_t* xr = C.XBC + m0 * NCONV + cc; const float* cw = C.in[I_CW] + cc; const float* cb = C.in[I_CB] + cc;
        f32x4 sv[3][2], wv[4][2], bv[2]; u32x4 rw[4];
#pragma unroll
        for (int k = 0; k < 3; ++k) { sv[k][0] = *(const f32x4*)(stp + k * NCONV); sv[k][1] = *(const f32x4*)(stp + k * NCONV + 4); }
#pragma unroll
        for (int k = 0; k < 4; ++k) { rw[k] = *(const u32x4*)(xr + (size_t)k * NCONV); wv[k][0] = *(const f32x4*)(cw + k * NCONV); wv[k][1] = *(const f32x4*)(cw + k * NCONV + 4); }
        bv[0] = *(const f32x4*)cb; bv[1] = *(const f32x4*)(cb + 4);
        float xp[7][8];
#pragma unroll
        for (int k = 0; k < 3; ++k) { xp[k][0] = sv[k][0].x; xp[k][1] = sv[k][0].y; xp[k][2] = sv[k][0].z; xp[k][3] = sv[k][0].w; xp[k][4] = sv[k][1].x; xp[k][5] = sv[k][1].y; xp[k][6] = sv[k][1].z; xp[k][7] = sv[k][1].w; }
#pragma unroll
        for (int k = 0; k < 4; ++k) unpack8(rw[k], xp[3 + k]);
#pragma unroll
        for (int t = 0; t < 4; ++t) {
            float o[8];
#pragma unroll
            for (int e = 0; e < 8; ++e) { float y = (e < 4) ? bv[0][e] : bv[1][e - 4];
#pragma unroll
                for (int k = 0; k < 4; ++k) y += ((e < 4) ? wv[k][0][e] : wv[k][1][e - 4]) * xp[t + k][e];
                o[e] = silu_f(y); }
            LAS float* dst = (tid < 32) ? Xs + ((tid >> 3) * 4 + t) * 64 + 8 * (tid & 7) : (tid < 48) ? Bs + t * 128 + 8 * (tid - 32) : Cs + t * 128 + 8 * (tid - 48);
#pragma unroll
            for (int e = 0; e < 8; ++e) dst[e] = o[e];
            if (t >= 1) { float* so = C.out + O_SCONV + (size_t)(b * 3 + t - 1) * NCONV + cc; *(f32x4*)so = (f32x4){xp[3 + t][0], xp[3 + t][1], xp[3 + t][2], xp[3 + t][3]}; *(f32x4*)(so + 4) = (f32x4){xp[3 + t][4], xp[3 + t][5], xp[3 + t][6], xp[3 + t][7]}; }
        }
    }
    if (tid < 16) Dts[tid] = softplus_f(C.DTRAW[(m0 + (tid & 3)) * 32 + g * 4 + (tid >> 2)] + C.in[I_DTB][g * 4 + (tid >> 2)]);
    __syncthreads();
    if (tid < 4) { const float A = -__expf(C.in[I_ALOG][g * 4 + tid]); float c = 0.f;
#pragma unroll
        for (int t = 0; t < 4; ++t) { c += Dts[tid * 4 + t] * A; Css[tid * 4 + t] = c; } }
    { const int pair = tid >> 5, l32 = tid & 31, t = pair >> 2, s = pair & 3; float a = 0.f;
#pragma unroll
      for (int k = 0; k < 4; ++k) a += Cs[t * 128 + l32 * 4 + k] * Bs[s * 128 + l32 * 4 + k];
#pragma unroll
      for (int o = 1; o < 32; o <<= 1) a += __shfl_xor(a, o);
      if (l32 == 0) Cbm[pair] = a; }
    __syncthreads();
#pragma unroll
    for (int hl = 0; hl < 4; ++hl) {
        const int h = g * 4 + hl; const size_t so = ((size_t)(b * 32 + h) * 64 + p) * 128 + ns * 4;
        float* sout = C.out + O_SSSM + so;
        float cst[4], dtt[4], xv[4], coef[4], yo[4];
#pragma unroll
        for (int t = 0; t < 4; ++t) { cst[t] = Css[hl * 4 + t]; dtt[t] = Dts[hl * 4 + t]; xv[t] = Xs[(hl * 4 + t) * 64 + p]; }
        const float cdec = __expf(cst[3]);
#pragma unroll
        for (int t = 0; t < 4; ++t) { coef[t] = __expf(cst[3] - cst[t]) * dtt[t] * xv[t]; yo[t] = 0.f; }
#pragma unroll
        for (int k = 0; k < 4; ++k) {
            const f32x4 h0 = hv[hl][k]; f32x4 hn = h0 * cdec;
#pragma unroll
            for (int t = 0; t < 4; ++t) {
                const f32x4 cv = *(const LAS f32x4*)(Cs + t * 128 + ns * 4 + 32 * k), bv = *(const LAS f32x4*)(Bs + t * 128 + ns * 4 + 32 * k);
                yo[t] += (cv.x * h0.x + cv.y * h0.y) + (cv.z * h0.z + cv.w * h0.w);
                hn += bv * coef[t];
            }
            __builtin_nontemporal_store(hn, (f32x4*)(sout + 32 * k));
        }
#pragma unroll
        for (int t = 0; t < 4; ++t) { yo[t] += __shfl_xor(yo[t], 1); yo[t] += __shfl_xor(yo[t], 2); yo[t] += __shfl_xor(yo[t], 4); }
        if (ns == 0) {
            const float Dh = C.in[I_SD][h];
#pragma unroll
            for (int t = 0; t < 4; ++t) {
                float y = __expf(cst[t]) * yo[t] + Dh * xv[t];
#pragma unroll
                for (int s = 0; s < 4; ++s) if (s <= t) y += Cbm[t * 4 + s] * __expf(cst[t] - cst[s]) * dtt[s] * xv[s];
                Yt[t * 256 + hl * 64 + p] = y;
            }
        }
    }
    __syncthreads();
    { const int t = tid >> 7, ch = (tid & 127) * 2; const size_t zo = (m0 + t) * DIN + g * 256 + ch;
      const unsigned zz = *(const unsigned*)(C.Z + zo);
      const float v0 = Yt[t * 256 + ch] * silu_f(bf2f(zz & 0xffffu)), v1 = Yt[t * 256 + ch + 1] * silu_f(bf2f(zz >> 16));
      const float ss = wave_sum(v0 * v0 + v1 * v1);
      if (lane == 0) Red[w] = ss;
      __syncthreads();
      const float rn = 1.0f / sqrtf((Red[2 * t] + Red[2 * t + 1]) * (1.0f / 256.0f) + RMS_EPS);
      *(unsigned*)(C.Z + zo) = pk2(v0 * rn, v1 * rn); }
    __syncthreads();
}
constexpr int SSU0 = 0, SSU1 = 1024;
__device__ __forceinline__ void sample_units(const Ctx& C, int lo, int hi) { for (int u = lo + C.bid; u < hi; u += C.G) ssd_sample_unit(C, u >> 3, u & 7); }
__device__ __forceinline__ void phase_ssd_states(const Ctx& C) {
    for (int u = C.bid; u < 1024; u += C.G) ssd_states_unit(C, u >> 3, u & 7);
    sample_units(C, 0, SSU0);
}
__device__ __forceinline__ void phase_ssd_scan(const Ctx& C) {
    const int gt = C.bid * NTHREADS + C.tid, NGT = C.G * NTHREADS;
    for (int id = gt; id < NBATCH * NSH * 64 * 16; id += NGT) {
        const int n8 = id & 15, p = (id >> 4) & 63, h = (id >> 10) & 31, b = id >> 15;
        float hs[8];
#pragma unroll
        for (int e = 0; e < 8; ++e) hs[e] = 0.f;
#pragma unroll 8
        for (int c = 0; c < NCHUNK; ++c) {
            const size_t off = ((size_t)((b * NCHUNK + c) * NSH + h) * 64 + p) * 128 + n8 * 8;
            const u32x4 sv = *(const u32x4*)(C.ST + off);
            *(u32x4*)(C.HP + off) = pack8(hs);
            float s[8]; unpack8(sv, s); const float dec = C.CDEC[(b * NCHUNK + c) * NSH + h];
#pragma unroll
            for (int e = 0; e < 8; ++e) hs[e] = hs[e] * dec + s[e];
        }
        float* op = C.out + O_PSSM + ((size_t)(b * NSH + h) * 64 + p) * 128 + n8 * 8;
        *(f32x4*)op = (f32x4){hs[0], hs[1], hs[2], hs[3]}; *(f32x4*)(op + 4) = (f32x4){hs[4], hs[5], hs[6], hs[7]};
    }
    __syncthreads();
    sample_units(C, SSU0, SSU1);
}
struct S3Pre { ConvRaw<16> Rc; u32x4 bst[4]; float dr0, dr1; };
__device__ __forceinline__ void s3_prefetch(const Ctx& C, int rb, int g, int r, int tid, S3Pre& P) {
    const size_t row0 = (size_t)rb * 128; const int lane = tid & 63;
#pragma unroll
    for (int i = 0; i < 4; ++i) { const int id = i * NTHREADS + tid, s = id >> 4, c2 = id & 15; P.bst[i] = *(const u32x4*)(C.XC + (row0 + s) * 3072 + 2048 + g * 128 + c2 * 8); }
    conv_load<16>(C, row0, (rb & 31) * 128, 3072 + g * 128, P.Rc);
    const float* dtp = C.DTRAW + (size_t)(rb * 128) * 32 + g * 4 + r; P.dr0 = dtp[(size_t)(2 * lane) * 32]; P.dr1 = dtp[(size_t)(2 * lane + 1) * 32];
}
__device__ __forceinline__ void ssd_out_unit(const Ctx& C, int rb, int g, S3Pre& P, bool has_next, int nrb, int ng) {
    int tid = (int)threadIdx.x; asm volatile("" : "+v"(tid));
    const int w = C.wave, lane = tid & 63, r = w >> 1, psel = w & 1, h = g * 4 + r, ql = lane & 31, hi = lane >> 5;
    LAS bf16_t* Cs = (LAS bf16_t*)C.lds;
    LAS f32x4* CBT = (LAS f32x4*)(C.lds + 34816);
    LAS float* CS = (LAS float*)(C.lds + 75776) + r * 256; LAS float* DTL = CS + 128;
    LAS float* SSQ = (LAS float*)(C.lds + 75776 + 4096);
    LAS bf16_t* Bs = (LAS bf16_t*)(C.lds + 81920);
    LAS bf16_t* Xs = (LAS bf16_t*)(C.lds + 81920);
    const size_t row0 = (size_t)rb * 128;
    const int t0 = (rb & 31) * 128;
    u32x4 xst[8];
#pragma unroll
    for (int i = 0; i < 8; ++i) { const int id = i * NTHREADS + tid, t = id >> 5, ch = id & 31; xst[i] = *(const u32x4*)(C.XC + (row0 + t) * 3072 + g * 256 + ch * 8); }
    {   u32x4 bvv[4]; const int ch = tid & 15, r0 = (tid >> 4) * 4;
#pragma unroll
        for (int i = 0; i < 4; ++i) { const int id = i * NTHREADS + tid, s = id >> 4, c2 = id & 15; *(LAS u32x4*)(Bs + s * 136 + c2 * 8) = P.bst[i]; }
        conv_compute<16>(C, 3072 + g * 128, P.Rc, bvv, ((rb & 31) == 31) ? C.out + O_PCONV + (size_t)(rb >> 5) * 3 * NCONV : nullptr);
#pragma unroll
        for (int i = 0; i < 4; ++i) *(LAS u32x4*)(Cs + (r0 + i) * 136 + ch * 8) = bvv[i];
    }
    bf16x8 hf[2][8];
#pragma unroll
    for (int pt = 0; pt < 2; ++pt) { const bf16_t* hp = C.HP + ((size_t)(rb * 32 + h) * 64 + 32 * pt + ql) * 128 + 8 * hi;
#pragma unroll
        for (int k = 0; k < 8; ++k) hf[pt][k] = *(const bf16x8*)(hp + 16 * k); }
    u32x4 zq[2][2];
#pragma unroll
    for (int pt = 0; pt < 2; ++pt)
#pragma unroll
        for (int j = 0; j < 2; ++j) {
            zq[pt][j]  = *(const u32x4*)(C.Z + (row0 + 32 * (psel ? 1 : 0) + ql) * DIN + h * 64 + 32 * pt + 16 * j + 8 * hi); }
    const float A = -__expf(C.in[I_ALOG][h]), Dh = C.in[I_SD][h];
    { float cs0, cs1, d0, d1, tot; chunk_scan_v(P.dr0, P.dr1, C.in[I_DTB][h], A, lane, cs0, cs1, d0, d1, tot);
      if (psel == 0) { CS[2 * lane] = cs0; CS[2 * lane + 1] = cs1; DTL[2 * lane] = d0; DTL[2 * lane + 1] = d1; } }
    __syncthreads();
    for (int tile = w; tile < 10; tile += NWAVES) {
        const int lt = (tile >= 6) ? 3 : (tile >= 3) ? 2 : (tile >= 1) ? 1 : 0, st = tile - lt * (lt + 1) / 2;
        f32x16 cb = zero16();
#pragma unroll
        for (int k = 0; k < 8; ++k) { const bf16x8 bfr = *(const LAS bf16x8*)(Bs + (32 * st + ql) * 136 + 16 * k + 8 * hi), cfr = *(const LAS bf16x8*)(Cs + (32 * lt + ql) * 136 + 16 * k + 8 * hi); cb = MFMA32(bfr, cfr, cb); }
#pragma unroll
        for (int q4 = 0; q4 < 4; ++q4) CBT[(tile * 4 + q4) * 64 + lane] = (f32x4){cb[4 * q4], cb[4 * q4 + 1], cb[4 * q4 + 2], cb[4 * q4 + 3]};
    }
    __syncthreads();
#pragma unroll
    for (int i = 0; i < 8; ++i) { const int id = i * NTHREADS + tid, t = id >> 5, ch = id & 31; *(LAS u32x4*)(Xs + t * XP + ch * 8) = xst[i]; }
    __syncthreads();
    const int li = lane & 15, gi = (lane >> 4) & 1;
    const LAS bf16_t* xt = Xs + (4 * hi + (li >> 2)) * XP + r * 64 + 16 * gi + 4 * (li & 3);
    for (int lq = 0; lq < 2; ++lq) {
        const int lt = psel ? (1 + lq) : (3 * lq), l = 32 * lt + ql; const size_t lrow = row0 + l;
        if (lq == 1) {
#pragma unroll
            for (int pt = 0; pt < 2; ++pt)
#pragma unroll
                for (int j = 0; j < 2; ++j) zq[pt][j] = *(const u32x4*)(C.Z + lrow * DIN + h * 64 + 32 * pt + 16 * j + 8 * hi);
        }
        if (lq == 1 && has_next) s3_prefetch(C, nrb, ng, r, tid, P);
        const float csl = CS[l];
        f32x16 Y[2]; Y[0] = zero16(); Y[1] = zero16();
        for (int st = 0; st <= lt; ++st) {
            const int tile = lt * (lt + 1) / 2 + st;
            float wv[16];
#pragma unroll
            for (int q4 = 0; q4 < 4; ++q4) {
                const int sb = 32 * st + 8 * q4 + 4 * hi;
                const f32x4 cb4 = CBT[(tile * 4 + q4) * 64 + lane];
                const f32x4 cs4 = *(const LAS f32x4*)(CS + sb), dt4 = *(const LAS f32x4*)(DTL + sb);
#pragma unroll
                for (int e = 0; e < 4; ++e) { const int s = sb + e; float v = cb4[e] * __expf(csl - cs4[e]) * dt4[e]; v = (s <= l) ? v : 0.f; if (s == l) v += Dh; wv[4 * q4 + e] = v; }
            }
            bf16x8 pf[2];
#pragma unroll
            for (int ks = 0; ks < 2; ++ks) { u32x4 pw; pw.x = pk2(wv[8 * ks], wv[8 * ks + 1]); pw.y = pk2(wv[8 * ks + 2], wv[8 * ks + 3]); pw.z = pk2(wv[8 * ks + 4], wv[8 * ks + 5]); pw.w = pk2(wv[8 * ks + 6], wv[8 * ks + 7]); pf[ks] = __builtin_bit_cast(bf16x8, pw); }
#pragma unroll
            for (int pt = 0; pt < 2; ++pt)
#pragma unroll
                for (int ks = 0; ks < 2; ++ks) {
                    const LAS bf16_t* xp = xt + (32 * st + 16 * ks) * XP + pt * 32;
                    const bf16x8 xf = cat8(lds_tr4(xp), lds_tr4(xp + 8 * XP));
                    Y[pt] = MFMA32(xf, pf[ks], Y[pt]);
                }
        }
        const float el = __expf(csl);
        bf16x8 cf[8];
#pragma unroll
        for (int k = 0; k < 8; ++k) cf[k] = *(const LAS bf16x8*)(Cs + l * 136 + 16 * k + 8 * hi);
#pragma unroll
        for (int pt = 0; pt < 2; ++pt) {
            f32x16 y2 = zero16();
#pragma unroll
            for (int k = 0; k < 8; ++k) y2 = MFMA32(hf[pt][k], cf[k], y2);
#pragma unroll
            for (int rg = 0; rg < 16; ++rg) Y[pt][rg] += el * y2[rg];
        }
        float ss = 0.f;
#pragma unroll
        for (int pt = 0; pt < 2; ++pt)
#pragma unroll
            for (int q4 = 0; q4 < 4; ++q4) {
                u32x2 z2;
                { const u32x4 zv = zq[pt][q4 >> 1];
                  auto s0 = __builtin_amdgcn_permlane32_swap(zv.x, zv.z, false, false); auto s1 = __builtin_amdgcn_permlane32_swap(zv.y, zv.w, false, false);
                  z2.x = (q4 & 1) ? s0[1] : s0[0]; z2.y = (q4 & 1) ? s1[1] : s1[0]; }
                const float z0 = bf2f(z2.x & 0xffffu), z1 = bf2f(z2.x >> 16), z2f = bf2f(z2.y & 0xffffu), z3 = bf2f(z2.y >> 16);
                float v;
                v = Y[pt][4 * q4 + 0] * silu_f(z0); Y[pt][4 * q4 + 0] = v; ss += v * v;
                v = Y[pt][4 * q4 + 1] * silu_f(z1); Y[pt][4 * q4 + 1] = v; ss += v * v;
                v = Y[pt][4 * q4 + 2] * silu_f(z2f); Y[pt][4 * q4 + 2] = v; ss += v * v;
                v = Y[pt][4 * q4 + 3] * silu_f(z3); Y[pt][4 * q4 + 3] = v; ss += v * v;
            }
        ss += __shfl_xor(ss, 32);
        if (hi == 0) SSQ[r * 128 + l] = ss;
        __syncthreads();
        const float tot = (SSQ[l] + SSQ[128 + l]) + (SSQ[256 + l] + SSQ[384 + l]);
        const float rn = 1.0f / sqrtf(tot * (1.0f / 256.0f) + RMS_EPS);
#pragma unroll
        for (int pt = 0; pt < 2; ++pt)
#pragma unroll
            for (int j = 0; j < 2; ++j) {
                const int qa = 2 * j, qb = 2 * j + 1;
                const unsigned x0 = pk2(Y[pt][4 * qa] * rn, Y[pt][4 * qa + 1] * rn), x1 = pk2(Y[pt][4 * qa + 2] * rn, Y[pt][4 * qa + 3] * rn);
                const unsigned y0 = pk2(Y[pt][4 * qb] * rn, Y[pt][4 * qb + 1] * rn), y1 = pk2(Y[pt][4 * qb + 2] * rn, Y[pt][4 * qb + 3] * rn);
                auto s0 = __builtin_amdgcn_permlane32_swap(x0, y0, false, false); auto s1 = __builtin_amdgcn_permlane32_swap(x1, y1, false, false);
                u32x4 ov; ov.x = s0[0]; ov.y = s1[0]; ov.z = s0[1]; ov.w = s1[1];
                *(u32x4*)(C.Z + lrow * DIN + h * 64 + 32 * pt + 16 * j + 8 * hi) = ov;
            }
    }
    __syncthreads();
}
__device__ __forceinline__ void phase_ssd_out(const Ctx& C) {
    { int u = C.bid; if (u < 1024) { S3Pre P; int t0_ = (int)threadIdx.x; asm volatile("" : "+v"(t0_)); s3_prefetch(C, u >> 3, u & 7, C.wave >> 1, t0_, P);
          for (; u < 1024; u += C.G) { const int nu = u + C.G; ssd_out_unit(C, u >> 3, u & 7, P, nu < 1024, nu >> 3, nu & 7); } } }
    sample_units(C, SSU1, 1024);
}
template <int K> __device__ __forceinline__ void skinny_resid(const Ctx& C, const bf16_t* A, const bf16_t* Bt) {
    constexpr int KC = 256, NCK = K / KC, SP = KC + 8, BUF = 96 * SP;
    static_assert(K % KC == 0, "K chunks");
    LAS bf16_t* buf = (LAS bf16_t*)C.lds;
    LAS float* red = (LAS float*)(C.lds + 2 * BUF * 2);
    int tid = (int)threadIdx.x; asm volatile("" : "+v"(tid));
    const int w = C.wave, lane = tid & 63, r16 = lane & 15, kq = lane >> 4, rt = w >> 2, ct = w & 3;
    for (int pc = C.bid; pc < 256; pc += C.G) {
        const int rg = pc >> 4, cgp = pc & 15;
        const bf16_t* src[6]; int dsto[6];
#pragma unroll
        for (int i = 0; i < 6; ++i) { const int id = i * NTHREADS + tid, row = id >> 5, ch = id & 31;
            src[i] = (row < 32 ? A + (size_t)(MP + 32 * rg + row) * K : Bt + (size_t)(64 * cgp + row - 32) * K) + ch * 8; dsto[i] = row * SP + ch * 8; }
        u32x4 st[2][6];
#pragma unroll
        for (int i = 0; i < 6; ++i) st[0][i] = *(const u32x4*)src[i];
        if (NCK > 1) {
#pragma unroll
            for (int i = 0; i < 6; ++i) st[1][i] = *(const u32x4*)(src[i] + KC); }
#pragma unroll
        for (int i = 0; i < 6; ++i) *(LAS u32x4*)(buf + dsto[i]) = st[0][i];
        __syncthreads();
        f32x4 acc = (f32x4){0.f, 0.f, 0.f, 0.f};
#pragma unroll
        for (int kc = 0; kc < NCK; ++kc) {
            if (kc + 2 < NCK) {
#pragma unroll
                for (int i = 0; i < 6; ++i) st[kc & 1][i] = *(const u32x4*)(src[i] + (size_t)(kc + 2) * KC); }
            const LAS bf16_t* ab = buf + (kc & 1) * BUF + (rt * 16 + r16) * SP + 8 * kq; const LAS bf16_t* bb = buf + (kc & 1) * BUF + (32 + ct * 16 + r16) * SP + 8 * kq;
#pragma unroll
            for (int ks = 0; ks < 8; ++ks) { const bf16x8 af = *(const LAS bf16x8*)(ab + 32 * ks), bfr = *(const LAS bf16x8*)(bb + 32 * ks); acc = __builtin_amdgcn_mfma_f32_16x16x32_bf16(bfr, af, acc, 0, 0, 0); }
            if (kc + 1 < NCK) {
#pragma unroll
                for (int i = 0; i < 6; ++i) *(LAS u32x4*)(buf + ((kc + 1) & 1) * BUF + dsto[i]) = st[(kc + 1) & 1][i]; }
            __syncthreads();
        }
        {
            const int srow = 32 * rg + rt * 16 + r16, col = 64 * cgp + 16 * ct + 4 * kq; const size_t grow = (size_t)MP + srow;
            const u32x2 ow = *(const u32x2*)(C.XB + grow * DM + col);
            f32x4 v = acc + (f32x4){bf2f(ow.x & 0xffffu), bf2f(ow.x >> 16), bf2f(ow.y & 0xffffu), bf2f(ow.y >> 16)};
            float ss = (v.x * v.x + v.y * v.y) + (v.z * v.z + v.w * v.w);
            ss += __shfl_xor(ss, 16); ss += __shfl_xor(ss, 32);
            u32x2 wv; wv.x = pk2(v.x, v.y); wv.y = pk2(v.z, v.w); *(u32x2*)(C.XB + grow * DM + col) = wv;
            if (kq == 0) red[(rt * 4 + ct) * 16 + r16] = ss;
        }
        __syncthreads();
        if (tid < 32) { const int rr = tid; const LAS float* rp = red + (rr >> 4) * 64 + (rr & 15);
            C.PART[((size_t)MP + 32 * rg + rr) * 16 + cgp] = (rp[0] + rp[16]) + (rp[32] + rp[48]); }
        __syncthreads();
    }
}
#define RLX_AGENT __ATOMIC_RELAXED, __HIP_MEMORY_SCOPE_AGENT
#define XB_TMO      128
#define XB_XCNT(j)  (256  + 64 * (j))
#define XB_XSUB(j)  (1280 + 64 * (j))
#define XB_XGEN(j)  (2304 + 64 * (j))
#define XB_TOP      3328
#define XB_TOPGEN   3392
#define XCD_BAR_WORDS 3456
#define XB_SPIN_CAP (1u << 18)

__device__ __forceinline__ unsigned xb_ld(unsigned* p)              { return __hip_atomic_load(p, __ATOMIC_RELAXED, __HIP_MEMORY_SCOPE_AGENT); }
__device__ __forceinline__ unsigned xb_add(unsigned* p, unsigned v) { return __hip_atomic_fetch_add(p, v, __ATOMIC_RELAXED, __HIP_MEMORY_SCOPE_AGENT); }
__device__ __forceinline__ unsigned xb_xcc_id() { return (unsigned)__builtin_amdgcn_s_getreg((3 << 11) | 20) & 0xFu; }
#define XB_SPIN(cond, bar) do { unsigned _sp = 0; while (cond) { __builtin_amdgcn_s_sleep(1); \
    if ((++_sp & 255u) == 0u) { if (xb_ld(&(bar)[XB_TMO])) break; if (_sp > XB_SPIN_CAP) { atomicAdd(&(bar)[XB_TMO], 1u); break; } } } } while (0)

struct XcdBarrier {
    unsigned* bar; unsigned x;
    volatile LAS unsigned* st;
};

__device__ __forceinline__ XcdBarrier xcd_barrier_post(unsigned* bar, volatile LAS unsigned* st) {
    XcdBarrier b; b.bar = bar; b.x = xb_xcc_id(); b.st = st;
    if (threadIdx.x == 0) (void)xb_add(&bar[XB_XCNT(b.x)], 1u);
    return b;
}
__device__ __forceinline__ void xcd_barrier_complete(unsigned* bar, unsigned x, unsigned& nloc, unsigned& nx) {
    const unsigned G = gridDim.x * gridDim.y * gridDim.z;
    unsigned sum, cnt, mine, sp = 0u;
    for (;;) {
        sum = 0u; cnt = 0u; mine = 0u;
#pragma unroll
        for (unsigned j = 0; j < 16; ++j) { const unsigned c = xb_ld(&bar[XB_XCNT(j)]); sum += c; cnt += (c > 0u) ? 1u : 0u; mine = (j == x) ? c : mine; }
        if (sum == G) break;
        __builtin_amdgcn_s_sleep(1);
        if ((++sp & 255u) == 0u) { if (xb_ld(&bar[XB_TMO])) break; if (sp > XB_SPIN_CAP) { atomicAdd(&bar[XB_TMO], 1u); break; } }
    }
    nloc = mine > 0u ? mine : 1u; nx = cnt > 0u ? cnt : 1u;
}

__device__ __forceinline__ void xcd_barrier(const XcdBarrier& b) {
    asm volatile("s_waitcnt vmcnt(0)" ::: "memory");
    __syncthreads();
    if (threadIdx.x == 0) {
        unsigned* bar = b.bar;
        __builtin_amdgcn_s_waitcnt(0);
        unsigned nloc = b.st[0], nx = b.st[1];
        if (nloc == 0u) { xcd_barrier_complete(bar, b.x, nloc, nx); b.st[0] = nloc; b.st[1] = nx; }
        const unsigned old = xb_add(&bar[XB_XSUB(b.x)], 1u);
        const unsigned gen = old / nloc;
        if (old + 1u == (gen + 1u) * nloc) {
            __builtin_amdgcn_fence(__ATOMIC_RELEASE, "agent");
            asm volatile("s_waitcnt vmcnt(0)" ::: "memory");
            const unsigned og = xb_add(&bar[XB_TOP], 1u);
            const unsigned tg = og / nx;
            if (og + 1u == (tg + 1u) * nx) xb_add(&bar[XB_TOPGEN], 1u);
            else XB_SPIN(xb_ld(&bar[XB_TOPGEN]) == tg, bar);
            __builtin_amdgcn_fence(__ATOMIC_ACQUIRE, "agent");
            xb_add(&bar[XB_XGEN(b.x)], 1u);
            asm volatile("s_waitcnt vmcnt(0)" ::: "memory");
        } else {
            XB_SPIN(xb_ld(&bar[XB_XGEN(b.x)]) == gen, bar);
            __builtin_amdgcn_fence(__ATOMIC_ACQUIRE, "agent");
            asm volatile("s_waitcnt vmcnt(0)" ::: "memory");
        }
    }
    __syncthreads();
}

#ifndef MK_ONE_LAUNCH
#define MK_ONE_LAUNCH 1
#endif
constexpr int N_PHASES = 17;
template <class Epi> __device__ __forceinline__ void run_gemm(const Ctx& C, const bf16_t* A, const bf16_t* Bt, int N, int K, const Epi& E, int M = MT) {
    pg8::Gemm g{A, Bt, M, N, K}; pg8::StaticOrder S; S.init(M, N, C.G, C.bid);
    if constexpr (Epi::NEEDS_RSTD) pg8::phase_rstd_table(E.part, S, E.RS);
    pg8::gemm_phase<Epi, pg8::StaticOrder, true, true>(C.lds, g, S, E);
}
__global__ void __launch_bounds__(NTHREADS, 2) hybrid_fwd(Args a) {
    extern __shared__ __attribute__((aligned(16))) unsigned char lds_raw[];
    Ctx C;
#pragma unroll
    for (int i = 0; i < 26; ++i) C.in[i] = a.in[i];
    C.out = a.out; C.ws = a.ws; C.lds = (LAS unsigned char*)lds_raw;
    C.tid = threadIdx.x; C.lane = C.tid & 63; C.wave = __builtin_amdgcn_readfirstlane(C.tid >> 6); C.G = gridDim.x; C.bid = blockIdx.x;
    unsigned char* ws = a.ws;
    C.PART = (float*)(ws + WS_PART); C.BIASD = (float*)(ws + WS_BIASD); C.CDEC = (float*)(ws + WS_CDEC); C.DTRAW = (float*)(ws + WS_DTRAW); C.U0 = (float*)(ws + WS_U0); C.UL = (float*)(ws + WS_UL);
    C.WQKV = (bf16_t*)(ws + WS_WQKV); C.WO = (bf16_t*)(ws + WS_WO); C.WIN = (bf16_t*)(ws + WS_WIN); C.WOUT = (bf16_t*)(ws + WS_WOUT); C.WUP = (bf16_t*)(ws + WS_WUP); C.WDN = (bf16_t*)(ws + WS_WDN);
    C.XB = (bf16_t*)(ws + WS_XB); C.QKV = (bf16_t*)(ws + WS_QKV); C.AO = (bf16_t*)(ws + WS_AO); C.ACT = (bf16_t*)(ws + WS_ACT); C.Z = (bf16_t*)(ws + WS_Z); C.XBC = (bf16_t*)(ws + WS_XBC);
    C.ST = (bf16_t*)(ws + WS_ST); C.HP = (bf16_t*)(ws + WS_HP); C.XC = (bf16_t*)(ws + WS_XC);
    const int lo = a.ph_lo, hi = a.ph_hi;
    volatile LAS unsigned* MISC = (volatile LAS unsigned*)(C.lds + LDSCTL_OFF);
    if (C.tid < 16) MISC[C.tid] = 0u;
    __syncthreads();
    XcdBarrier bar; bar.bar = (unsigned*)(ws + WS_CTL); bar.x = 0; bar.st = nullptr;
    if (a.coop) bar = xcd_barrier_post((unsigned*)(ws + WS_CTL), MISC + 8);
#define IN(k) (lo <= (k) && (k) < hi)
#define FRESH() do { int t_ = threadIdx.x; asm volatile("" : "+v"(t_)); C.tid = t_; C.lane = t_ & 63; C.wave = __builtin_amdgcn_readfirstlane(t_ >> 6); } while (0)
#ifndef CG_SEAM_MASK
#define CG_SEAM_MASK 0x0u
#endif
#define SEAM(k) do { if (IN(k) && IN((k) + 1)) { if ((CG_SEAM_MASK >> (k)) & 1u) cg::this_grid().sync(); else xcd_barrier(bar); } } while (0)
    if (IN(0)) { FRESH(); phase_prologue(C);  __syncthreads(); } SEAM(0);
    if (IN(1)) { FRESH(); pg8::EpiScale<0> E{C.PART, C.QKV, NQKV, nullptr, nullptr, (LAS float*)(C.lds + RING_BYTES + 16384)}; run_gemm(C, C.XB, C.WQKV, NQKV, DM, E); convert_in_tail<1>(C, (MT / 256) * (NQKV / 256));  __syncthreads(); } SEAM(1);
    if (IN(2)) { FRESH(); phase_attention(C);  __syncthreads(); } SEAM(2);
    if (IN(3)) { FRESH(); pg8::EpiResid E{C.XB, C.PART}; run_gemm(C, C.AO, C.WO, DM, DM, E, MP); skinny_resid<DM>(C, C.AO, C.WO);  __syncthreads(); } SEAM(3);
    if (IN(4)) { FRESH(); pg8::EpiConvAct E{C.PART, C.ACT, C.in[I_FCW], C.in[I_FCB], C.in[I_SFFN], C.U0, C.UL, C.out + O_PFFN, C.out + O_SFFN, (LAS float*)(C.lds + RING_BYTES), (LAS float*)(C.lds + RING_BYTES + 16384), (LAS float*)(C.lds + RING_BYTES + 8192)}; run_gemm(C, C.XB, C.WUP, NUP, DM, E); convert_in_tail<2>(C, (MT / 256) * (NUP / 256));  __syncthreads(); } SEAM(4);
    if (IN(6)) { FRESH(); { pg8::StaticOrder S_; pg8::Unit u_; S_.init(MP, DM, C.G, C.bid); for (int i_ = 0; S_.next(i_, u_); ++i_) ffn_fixup_tile(C, 0, u_.pm); } pg8::EpiResid E{C.XB, C.PART}; run_gemm(C, C.ACT, C.WDN, DM, DFF, E, MP); skinny_resid<DFF>(C, C.ACT, C.WDN);  __syncthreads(); } SEAM(6);
    if (IN(7)) { FRESH(); pg8::EpiScale<2> E{C.PART, C.Z, DIN, C.XBC, C.DTRAW, (LAS float*)(C.lds + RING_BYTES + 16384)}; run_gemm(C, C.XB, C.WIN, NINP, DM, E); convert_in_tail<3>(C, (MT / 256) * (NINP / 256));  __syncthreads(); } SEAM(7);
    if (IN(9)) { FRESH(); phase_ssd_states(C);  __syncthreads(); } SEAM(9);
    if (IN(10)) { FRESH(); phase_ssd_scan(C);  __syncthreads(); } SEAM(10);
    if (IN(11)) { FRESH(); phase_ssd_out(C);  __syncthreads(); } SEAM(11);
    if (IN(12)) { FRESH(); pg8::EpiResid E{C.XB, C.PART}; run_gemm(C, C.Z, C.WOUT, DM, DIN, E, MP); skinny_resid<DIN>(C, C.Z, C.WOUT);  __syncthreads(); } SEAM(12);
    if (IN(13)) { FRESH(); pg8::EpiConvAct E{C.PART, C.ACT, C.in[I_FCW] + 3 * NUP, C.in[I_FCB] + NUP, C.in[I_SFFN] + (size_t)SBATCH * 2 * NUP, C.U0, C.UL, C.out + O_PFFN + 4 * 2 * NUP, C.out + O_SFFN + (size_t)SBATCH * 2 * NUP, (LAS float*)(C.lds + RING_BYTES), (LAS float*)(C.lds + RING_BYTES + 16384), (LAS float*)(C.lds + RING_BYTES + 8192)}; run_gemm(C, C.XB, C.WUP + (size_t)NUP * DM, NUP, DM, E); convert_in_tail<4>(C, (MT / 256) * (NUP / 256));  __syncthreads(); } SEAM(13);
    if (IN(15)) { FRESH(); { pg8::StaticOrder S_; pg8::Unit u_; S_.init(MP, DM, C.G, C.bid); for (int i_ = 0; S_.next(i_, u_); ++i_) ffn_fixup_tile(C, 1, u_.pm); } pg8::EpiResid E{C.XB, C.PART}; run_gemm(C, C.ACT, C.WDN + (size_t)DM * DFF, DM, DFF, E, MP); skinny_resid<DFF>(C, C.ACT, C.WDN + (size_t)DM * DFF);  __syncthreads(); } SEAM(15);
    if (IN(16)) { FRESH(); phase_final_norm(C); __syncthreads(); }
#undef IN
#undef SEAM
}

extern "C" void kernel_launch(void* const* d_in, const int* in_sizes, int n_in, void* d_out, int out_size, void* d_ws, size_t ws_size, hipStream_t stream) {
    static int grid = 0;
    if (grid == 0) {
        if (n_in != 26 || (size_t)out_size != O_END || ws_size < WS_END) { fprintf(stderr, "kernel_launch: unexpected problem: n_in %d out %d ws %zu (need %zu)\n", n_in, out_size, ws_size, (size_t)WS_END); grid = -1; return; }
        int dev = 0, cus = 0, per_cu = 0;
        if (hipGetDevice(&dev) != hipSuccess || hipDeviceGetAttribute(&cus, hipDeviceAttributeMultiprocessorCount, dev) != hipSuccess) { grid = -1; return; }
        if (hipFuncSetAttribute((const void*)hybrid_fwd, hipFuncAttributeMaxDynamicSharedMemorySize, LDS_BYTES) != hipSuccess) { fprintf(stderr, "kernel_launch: hipFuncSetAttribute failed\n"); grid = -1; return; }
        if (hipOccupancyMaxActiveBlocksPerMultiprocessor(&per_cu, (const void*)hybrid_fwd, NTHREADS, LDS_BYTES) != hipSuccess || per_cu < 1) { fprintf(stderr, "kernel_launch: occupancy query says %d\n", per_cu); per_cu = 1; (void)hipGetLastError(); }
        grid = cus * (per_cu > 1 ? 1 : per_cu);
    }
    if (grid < 0) return;
    Args a{};
    for (int i = 0; i < 26; ++i) a.in[i] = (const float*)d_in[i];
    a.out = (float*)d_out; a.ws = (unsigned char*)d_ws;
#if MK_ONE_LAUNCH
    if (hipMemsetAsync((char*)d_ws + WS_CTL, 0, 16384, stream) != hipSuccess) { fprintf(stderr, "kernel_launch: memset failed\n"); return; }
    a.ph_lo = 0; a.ph_hi = N_PHASES; a.coop = 1;
    void* args[] = {&a};
    hipError_t e = hipLaunchCooperativeKernel((const void*)hybrid_fwd, dim3(grid), dim3(NTHREADS), args, LDS_BYTES, stream);
    if (e != hipSuccess) fprintf(stderr, "kernel_launch: cooperative launch failed: %s (grid %d)\n", hipGetErrorString(e), grid);
#else
    for (int p = 0; p < N_PHASES; ++p) {
        a.ph_lo = p; a.ph_hi = p + 1; a.coop = 0;
        hipLaunchKernelGGL(hybrid_fwd, dim3(grid), dim3(NTHREADS), LDS_BYTES, stream, a);
    }
#endif
}
```

```cpp
#include <hip/hip_runtime.h>
#include <hip/hip_cooperative_groups.h>
#include <cstdio>
#include <cstdint>
namespace cg = cooperative_groups;

#define LAS __attribute__((address_space(3)))
typedef unsigned short bf16_t;
typedef short bf16x8 __attribute__((ext_vector_type(8)));
typedef short s16x4 __attribute__((ext_vector_type(4)));
typedef float f32x4 __attribute__((ext_vector_type(4)));
typedef float f32x2 __attribute__((ext_vector_type(2)));
typedef float f32x16 __attribute__((ext_vector_type(16)));
typedef unsigned u32x4 __attribute__((ext_vector_type(4)));
typedef unsigned u32x2 __attribute__((ext_vector_type(2)));
typedef __bf16 bf16x2_t __attribute__((ext_vector_type(2)));

constexpr int DM = 1024, NBATCH = 4, SEQ = 4096, MP = NBATCH * SEQ, SBATCH = 128, SLEN = 4, MS = SBATCH * SLEN, MT = MP + MS;
constexpr int NQKV = 1536, DFF = 2816, NUP = 2 * DFF, DIN = 2048, NCONV = 4096, NIN = 6176, NINP = 6400, NSH = 32, NSG = 8, DSTATE = 128;
constexpr int NCHUNK = SEQ / 128;
constexpr float RMS_EPS = 1e-6f;
constexpr float LOG2E = 1.4426950408889634f;

constexpr size_t MiB = 1u << 20;
constexpr size_t WS_CTL = 0;
constexpr size_t WS_PART = 1 * MiB;
constexpr size_t WS_BIASD = 3 * MiB;
constexpr size_t WS_CDEC = 3 * MiB + 65536;
constexpr size_t WS_DTRAW = 4 * MiB;
constexpr size_t WS_WQKV = 12 * MiB, WS_WO = 15 * MiB, WS_WIN = 17 * MiB, WS_WOUT = 30 * MiB, WS_WUP = 34 * MiB  , WS_WDN = 56 * MiB  ;
constexpr size_t WS_XB = 67 * MiB;
constexpr size_t WS_OV = 133 * MiB;
constexpr size_t WS_QKV = WS_OV, WS_AO = WS_OV + 50 * MiB;
constexpr size_t WS_U0 = WS_OV, WS_UL = WS_OV + 3 * MiB, WS_ACT = WS_OV + 182 * MiB;
constexpr size_t WS_Z = WS_OV, WS_XBC = WS_OV + 66 * MiB;
constexpr size_t WS_ST = WS_OV + 198 * MiB, WS_HP = WS_ST;
constexpr size_t WS_XC = WS_OV + 262 * MiB;
constexpr size_t WS_END = WS_OV + 361 * MiB;
static_assert(WS_WQKV + (size_t)NQKV * DM * 2 <= WS_WO && WS_WO + (size_t)DM * DM * 2 <= WS_WIN && WS_WIN + (size_t)NINP * DM * 2 <= WS_WOUT && WS_WOUT + (size_t)DM * DIN * 2 <= WS_WUP &&
              WS_WUP + 2 * (size_t)NUP * DM * 2 <= WS_WDN && WS_WDN + 2 * (size_t)DM * DFF * 2 <= WS_XB && WS_XB + (size_t)MT * DM * 2 <= WS_OV, "weights map");
static_assert(WS_QKV + (size_t)MT * NQKV * 2 <= WS_AO && WS_AO + (size_t)MT * DM * 2 <= WS_END && WS_UL + (size_t)66 * 2 * NUP * 4 <= WS_ACT && WS_U0 + (size_t)66 * 2 * NUP * 4 <= WS_UL && WS_ACT + (size_t)MT * DFF * 2 <= WS_END &&
              WS_Z + (size_t)MT * DIN * 2 <= WS_XBC && WS_XBC + (size_t)MT * NCONV * 2 <= WS_ST && WS_ST + (size_t)MP * DIN * 2 <= WS_XC && WS_XC + (size_t)MP * 3072 * 2 <= WS_END &&
              WS_PART + (size_t)MT * 64 <= WS_BIASD && WS_DTRAW + (size_t)MT * 128 <= WS_WQKV, "overlay map");

constexpr size_t O_YP = 0, O_YS = O_YP + (size_t)MP * DM, O_PK = O_YS + (size_t)MS * DM, O_PV = O_PK + 4 * 128 * 256, O_PCONV = O_PV + 4 * 128 * 256, O_PSSM = O_PCONV + 4 * 3 * NCONV,
                 O_PFFN = O_PSSM + (size_t)4 * 32 * 64 * 128, O_SK = O_PFFN + 2 * 4 * 2 * NUP, O_SV = O_SK + (size_t)128 * 128 * 256, O_SCONV = O_SV + (size_t)128 * 128 * 256,
                 O_SSSM = O_SCONV + (size_t)128 * 3 * NCONV, O_SFFN = O_SSSM + (size_t)128 * 32 * 64 * 128, O_END = O_SFFN + (size_t)2 * 128 * 2 * NUP;

__device__ __forceinline__ float bf2f(unsigned v) { return __uint_as_float(v << 16); }
__device__ __forceinline__ unsigned pk2(float lo, float hi) { f32x2 v = {lo, hi}; bf16x2_t b = __builtin_convertvector(v, bf16x2_t); return __builtin_bit_cast(unsigned, b); }
__device__ __forceinline__ float wave_sum(float v) {
#pragma unroll
    for (int o = 1; o < 64; o <<= 1) v += __shfl_xor(v, o);
    return v;
}
__device__ __forceinline__ float wave_max(float v) {
#pragma unroll
    for (int o = 1; o < 64; o <<= 1) v = fmaxf(v, __shfl_xor(v, o));
    return v;
}
__device__ __forceinline__ float silu_f(float v) { return v * __builtin_amdgcn_rcpf(1.0f + __builtin_amdgcn_exp2f(-LOG2E * v)); }
__device__ __forceinline__ int crow(int r, int hi) { return (r & 3) + 8 * (r >> 2) + 4 * hi; }
__device__ __forceinline__ void unpack8(const u32x4 v, float (&f)[8]) {
    f[0] = bf2f(v.x & 0xffffu); f[1] = bf2f(v.x >> 16); f[2] = bf2f(v.y & 0xffffu); f[3] = bf2f(v.y >> 16);
    f[4] = bf2f(v.z & 0xffffu); f[5] = bf2f(v.z >> 16); f[6] = bf2f(v.w & 0xffffu); f[7] = bf2f(v.w >> 16);
}
__device__ __forceinline__ u32x4 pack8(const float (&f)[8]) { u32x4 o; o.x = pk2(f[0], f[1]); o.y = pk2(f[2], f[3]); o.z = pk2(f[4], f[5]); o.w = pk2(f[6], f[7]); return o; }
__device__ __forceinline__ float row_rstd(const float* part, int row) {
    const f32x4* p = (const f32x4*)(part + (size_t)row * 16);
    const f32x4 a = p[0], b = p[1], c = p[2], d = p[3];
    const float s = ((a.x + a.y) + (a.z + a.w)) + ((b.x + b.y) + (b.z + b.w)) + ((c.x + c.y) + (c.z + c.w)) + ((d.x + d.y) + (d.z + d.w));
    return 1.0f / sqrtf(s * (1.0f / DM) + RMS_EPS);
}
namespace pg8 {
#define PG8_LAS __attribute__((address_space(3)))
typedef unsigned short bf16_t;
typedef short bf16x8 __attribute__((ext_vector_type(8)));
typedef float f32x4 __attribute__((ext_vector_type(4)));
typedef unsigned u32x4 __attribute__((ext_vector_type(4)));
constexpr int BM = 256, BK = 64, HALF = 128, HTB = HALF * BK * 2  , STAGE_BYTES = 8 * HTB, NXCD = 8, WGM = 8;

__host__ __device__ __forceinline__ int lds_byte(int r, int c) { const int st = (r >> 4) * 2 + (c >> 5), rr = r & 15, cc = c & 31, ob = rr * 64 + cc * 2; return st * 1024 + (ob ^ (((ob >> 9) & 1) << 5)); }
__host__ __device__ __forceinline__ void stage_rc(int b, int& R, int& C) { const int st = b / 1024, sb = b % 1024, swz = sb ^ (((sb >> 9) & 1) << 5); R = (st >> 1) * 16 + swz / 64; C = (st & 1) * 32 + (swz % 64) / 2; }
__host__ __device__ __forceinline__ int perm32(int rho) { const int n = rho >> 4, i = rho & 15; return 8 * (i >> 2) + 4 * n + (i & 3); }

struct Unit { int pm, pn, idx; };
struct Gemm { const bf16_t* A; const bf16_t* Bt; int M, N, K; };

struct StaticOrder {
    int nM, nN, nwg, G, c;
    __host__ __device__ __forceinline__ void init(int M, int N, int G_, int c_) { nM = M / BM; nN = N / BM; nwg = nM * nN; G = G_; c = c_; }
    __host__ __device__ __forceinline__ bool next(int i, Unit& u) const {
        const long L = (long)i * G + c; if (L >= nwg) return false;
        int wgid = (int)L; { const int q = nwg / NXCD, r = nwg % NXCD, xcd = wgid % NXCD, off = wgid / NXCD; wgid = (xcd < r ? xcd * (q + 1) : r * (q + 1) + (xcd - r) * q) + off; }
        const int nig = WGM * nN, gid = wgid / nig, fm = gid * WGM, gsz = (nM - fm) < WGM ? (nM - fm) : WGM;
        u.pm = fm + ((wgid % nig) % gsz); u.pn = (wgid % nig) / gsz; u.idx = i; return true;
    }
    __device__ __forceinline__ void a_ready(const Unit&) const {}
    __device__ __forceinline__ void done(const Unit&) const {}
};


template <class Sched> __device__ __forceinline__ void phase_rstd_table(const float* part, const Sched& S, PG8_LAS float* RS) {
    Unit u; const int t = threadIdx.x;
    for (int i = 0; S.next(i, u); ++i) if (t < 256) RS[i * 256 + t] = row_rstd(part, u.pm * BM + t);
    __syncthreads();
}
#define PG8_EPI_BARRIER() do { asm volatile("s_waitcnt lgkmcnt(0)" ::: "memory"); __builtin_amdgcn_s_barrier(); asm volatile("" ::: "memory"); } while (0)
template <int MODE> struct EpiScale {
    static constexpr bool PERM = true, AFTER_DRAIN = false, NEEDS_RSTD = true, WANTS_NEXT = false;
    const float* part; bf16_t* O0; int ldc; bf16_t* O1; float* F; PG8_LAS float* RS;
    __device__ __forceinline__ void operator()(const f32x4 (&acc)[2][2][4][2], const Unit& u, int wr, int wc, int fr, int fq) const {
        const int colt = u.pn * BM; bf16_t* base = O0; int ld = ldc, cl = colt; bool dtile = false;
        if (MODE == 2) { if (colt < 2048) { base = O0; ld = 2048; cl = colt; } else if (colt < 6144) { base = O1; ld = 4096; cl = colt - 2048; } else { dtile = true; } }
        const int row0 = u.pm * BM + wr * 64 + fr, col0 = cl + wc * 32 + 8 * fq;
#pragma unroll
        for (int ai = 0; ai < 2; ++ai)
#pragma unroll
            for (int m = 0; m < 4; ++m) {
                const int row = row0 + ai * HALF + m * 16; const float rs = RS[u.idx * 256 + ai * HALF + wr * 64 + m * 16 + fr];
                if (MODE == 2 && dtile) {
                    if (wc == 0) { float* fp = F + (size_t)row * 32 + 8 * fq; *(f32x4*)fp = acc[ai][0][m][0] * rs; *(f32x4*)(fp + 4) = acc[ai][0][m][1] * rs; }
                } else {
                    bf16_t* rowp = base + (size_t)row * ld + col0;
#pragma unroll
                    for (int bj = 0; bj < 2; ++bj) { const f32x4 v0 = acc[ai][bj][m][0] * rs, v1 = acc[ai][bj][m][1] * rs;
                        u32x4 w; w.x = pk2(v0[0], v0[1]); w.y = pk2(v0[2], v0[3]); w.z = pk2(v1[0], v1[1]); w.w = pk2(v1[2], v1[3]);
                        *(u32x4*)(rowp + bj * HALF) = w; }
                }
            }
    }
};
__device__ __forceinline__ float dpp_ror1(float v) { return __builtin_bit_cast(float, __builtin_amdgcn_update_dpp(0, __builtin_bit_cast(int, v), 0x121, 0xf, 0xf, false)); }
__device__ __forceinline__ float dpp_ror2(float v) { return __builtin_bit_cast(float, __builtin_amdgcn_update_dpp(0, __builtin_bit_cast(int, v), 0x122, 0xf, 0xf, false)); }
__device__ __forceinline__ float dpp_shr1(float old, float v) { return __builtin_bit_cast(float, __builtin_amdgcn_update_dpp(__builtin_bit_cast(int, old), __builtin_bit_cast(int, v), 0x111, 0xf, 0xf, false)); }
__device__ __forceinline__ float dpp_shr2(float old, float v) { return __builtin_bit_cast(float, __builtin_amdgcn_update_dpp(__builtin_bit_cast(int, old), __builtin_bit_cast(int, v), 0x112, 0xf, 0xf, false)); }
struct EpiConvAct {
    static constexpr bool PERM = true, AFTER_DRAIN = false, NEEDS_RSTD = true, WANTS_NEXT = true;
    const float* part; bf16_t* ACT; const float* cw; const float* cb; const float* st; float* U0; float* UL; float* outp; float* outs; PG8_LAS float* X; PG8_LAS float* RS; PG8_LAS float* W;
    __device__ __forceinline__ void operator()(const f32x4 (&acc)[2][2][4][2], const Unit& u, const Unit& nx, bool has_next, int wr, int wc, int fr, int fq) const {
        const int pm = u.pm, pn = u.pn; const bool samp = pm >= MP / BM;
        const int ch0 = pn * 128 + wc * 32 + 8 * fq;
        PG8_LAS float* Wc = W + (u.idx & 1) * 1024; PG8_LAS float* Wn = W + ((u.idx + 1) & 1) * 1024;
        const int tw = wc * 64 + fq * 16 + fr, warr = tw >> 5, wc4 = tw & 31;
        const float* wsrc = ((warr & 3) == 3 ? cb : cw + (warr & 3) * NUP) + ((warr >> 2) ? DFF : 0) + 4 * wc4;
        if (wr == 1 && u.idx == 0) *(PG8_LAS f32x4*)(Wc + 4 * tw) = *(const f32x4*)(wsrc + pn * 128);
        f32x4 wnx = (f32x4){0.f, 0.f, 0.f, 0.f};
        if (wr == 1 && has_next) wnx = *(const f32x4*)(wsrc + nx.pn * 128);
        if (fr >= 14) {
#pragma unroll
            for (int ai = 0; ai < 2; ++ai) { PG8_LAS float* xp = X + ((((ai * 2 + wr) * 4 + wc) * 2 + (fr - 14)) * 4 + fq) * 16;
#pragma unroll
                for (int bj = 0; bj < 2; ++bj)
#pragma unroll
                    for (int n = 0; n < 2; ++n) *(PG8_LAS f32x4*)(xp + bj * 8 + n * 4) = acc[ai][bj][3][n]; }
        }
        PG8_EPI_BARRIER();
        float rs[2][4];
#pragma unroll
        for (int ai = 0; ai < 2; ++ai)
#pragma unroll
            for (int m = 0; m < 4; ++m) rs[ai][m] = RS[u.idx * 256 + ai * HALF + wr * 64 + m * 16 + fr];
        const int sq = fr & 3;
#pragma unroll
        for (int n = 0; n < 2; ++n) {
            const int ch = ch0 + 4 * n;
            const PG8_LAS float* wp = Wc + wc * 32 + 8 * fq + 4 * n;
            const f32x4 wa0 = *(const PG8_LAS f32x4*)wp, wa1 = *(const PG8_LAS f32x4*)(wp + 128), wa2 = *(const PG8_LAS f32x4*)(wp + 256), ba = *(const PG8_LAS f32x4*)(wp + 384);
            const f32x4 wb0 = *(const PG8_LAS f32x4*)(wp + 512), wb1 = *(const PG8_LAS f32x4*)(wp + 640), wb2 = *(const PG8_LAS f32x4*)(wp + 768), bb = *(const PG8_LAS f32x4*)(wp + 896);
#pragma unroll
            for (int ai = 0; ai < 2; ++ai) {
                f32x4 pa = (f32x4){0.f, 0.f, 0.f, 0.f}, pb = pa;
                if (wr == 1 || ai == 1) {
                    const int sai = (wr == 1) ? ai : 0, swr = (wr == 1) ? 0 : 1;
                    const PG8_LAS float* xp = X + ((((sai * 2 + swr) * 4 + wc) * 2 + ((fr == 15) ? 1 : 0)) * 4 + fq) * 16 + n * 4;
                    const float prs = RS[u.idx * 256 + ai * HALF + wr * 64 - ((fr == 15) ? 1 : 2)];
                    pa = *(const PG8_LAS f32x4*)xp * prs; pb = *(const PG8_LAS f32x4*)(xp + 8) * prs;
                }
#pragma unroll
                for (int m = 0; m < 4; ++m) {
                    const int row = pm * BM + ai * HALF + wr * 64 + m * 16 + fr;
                    const f32x4 ca = acc[ai][0][m][n] * rs[ai][m], cv = acc[ai][1][m][n] * rs[ai][m];
                    f32x4 p1a, p2a, p1b, p2b;
#pragma unroll
                    for (int e = 0; e < 4; ++e) {
                        p1a[e] = dpp_shr1(dpp_ror1(pa[e]), ca[e]); p2a[e] = dpp_shr2(dpp_ror2(pa[e]), ca[e]);
                        p1b[e] = dpp_shr1(dpp_ror1(pb[e]), cv[e]); p2b[e] = dpp_shr2(dpp_ror2(pb[e]), cv[e]);
                    }
                    if (samp) {
                        const float* sp = st + (size_t)((row - MP) >> 2) * 2 * NUP + ch;
                        if (sq == 0) { p2a = *(const f32x4*)sp; p2b = *(const f32x4*)(sp + DFF); p1a = *(const f32x4*)(sp + NUP); p1b = *(const f32x4*)(sp + NUP + DFF); }
                        else if (sq == 1) { p2a = *(const f32x4*)(sp + NUP); p2b = *(const f32x4*)(sp + NUP + DFF); }
                    }
                    const f32x4 ya = ba + wa0 * p2a + wa1 * p1a + wa2 * ca, yb = bb + wb0 * p2b + wb1 * p1b + wb2 * cv;
                    const bool first2 = (ai == 0 && wr == 0 && m == 0 && fr < 2), last2 = (ai == 1 && wr == 1 && m == 3 && fr >= 14);
                    if (!(first2 && !samp && (pm & 15) != 0)) {
                        u32x2 ov; ov.x = pk2(silu_f(ya[0]) * yb[0], silu_f(ya[1]) * yb[1]); ov.y = pk2(silu_f(ya[2]) * yb[2], silu_f(ya[3]) * yb[3]);
                        *(u32x2*)(ACT + (size_t)row * DFF + ch) = ov;
                    }
                    if (first2) { float* up = U0 + (size_t)(pm * 2 + fr) * NUP + ch; *(f32x4*)up = ca; *(f32x4*)(up + DFF) = cv; }
                    if (last2) { float* up = UL + (size_t)(pm * 2 + fr - 14) * NUP + ch; *(f32x4*)up = ca; *(f32x4*)(up + DFF) = cv;
                        if (!samp && (pm & 15) == 15) { float* op = outp + (size_t)((pm >> 4) * 2 + fr - 14) * NUP + ch; *(f32x4*)op = ca; *(f32x4*)(op + DFF) = cv; } }
                    if (samp && sq >= 2) { float* op = outs + (size_t)(((row - MP) >> 2) * 2 + sq - 2) * NUP + ch; *(f32x4*)op = ca; *(f32x4*)(op + DFF) = cv; }
                    pa = ca; pb = cv;
                    asm volatile("" ::: "memory");
                }
            }
        }
        if (wr == 1 && has_next) *(PG8_LAS f32x4*)(Wn + 4 * tw) = wnx;
    }
};
struct EpiResid {
    static constexpr bool PERM = true, AFTER_DRAIN = false, NEEDS_RSTD = false, WANTS_NEXT = false;
    bf16_t* XB; float* part;
    __device__ __forceinline__ void operator()(const f32x4 (&acc)[2][2][4][2], const Unit& u, int wr, int wc, int fr, int fq) const {
        const int row0 = u.pm * BM + wr * 64 + fr, col0 = u.pn * BM + wc * 32 + 8 * fq;
#pragma unroll
        for (int ai = 0; ai < 2; ++ai)
#pragma unroll
            for (int m = 0; m < 4; ++m) {
                const int row = row0 + ai * HALF + m * 16;
                float ss = 0.f;
#pragma unroll
                for (int bj = 0; bj < 2; ++bj) { bf16_t* xp = XB + (size_t)row * DM + col0 + bj * HALF;
                    float o[8]; unpack8(*(const u32x4*)xp, o);
                    const f32x4 v0 = (f32x4){o[0], o[1], o[2], o[3]} + acc[ai][bj][m][0], v1 = (f32x4){o[4], o[5], o[6], o[7]} + acc[ai][bj][m][1];
                    ss += (v0[0] * v0[0] + v0[1] * v0[1]) + (v0[2] * v0[2] + v0[3] * v0[3]) + (v1[0] * v1[0] + v1[1] * v1[1]) + (v1[2] * v1[2] + v1[3] * v1[3]);
                    u32x4 w; w.x = pk2(v0[0], v0[1]); w.y = pk2(v0[2], v0[3]); w.z = pk2(v1[0], v1[1]); w.w = pk2(v1[2], v1[3]);
                    *(u32x4*)xp = w; }
                ss += __shfl_xor(ss, 16); ss += __shfl_xor(ss, 32);
                if (fq == 0) part[(size_t)row * 16 + u.pn * 4 + wc] = ss;
            }
    }
};

template <class Epi, class Sched, bool ALIGN_EPI = false, bool SP2 = false>
__device__ __forceinline__ void gemm_phase(PG8_LAS unsigned char* lds, const Gemm g, const Sched& S, const Epi& E) {
    const int tid = threadIdx.x, wid = __builtin_amdgcn_readfirstlane(tid >> 6), lane = tid & 63, wr = wid >> 2, wc = wid & 3, fr = lane & 15, fq = lane >> 4;
    const int K = g.K, nt = K / BK;
    unsigned voffA[2], voffB[2];
#pragma unroll
    for (int i = 0; i < 2; ++i) { int R, C; stage_rc(tid * 16 + i * 8192, R, C); const int Rb = Epi::PERM ? ((R & ~31) + perm32(R & 31)) : R;
        voffA[i] = (unsigned)(R * K + C) * 2u; voffB[i] = (unsigned)(Rb * K + C) * 2u; }
    const size_t kstep = (size_t)(BK * 2);
    const size_t hstep = (size_t)HALF * K * 2;
    const size_t tstep = 2 * hstep;
    const unsigned ldsw = (unsigned)wid * 1024u;
    const int aoff = lds_byte(wr * 64 + fr, fq * 8), boff = lds_byte(wc * 32 + fr, fq * 8);
#define PG8_SA(b, h) (((b) * 2 + (h)) * HTB)
#define PG8_SB(b, h) ((4 + (b) * 2 + (h)) * HTB)
#define PG8_STAGE(bufoff, gbase, voff) do { _Pragma("unroll") for (int _i = 0; _i < 2; ++_i) \
        __builtin_amdgcn_global_load_lds((const unsigned*)((const char*)(gbase) + (voff)[_i]), (PG8_LAS unsigned*)(lds + (bufoff) + ldsw + _i * 8192), 16, 0, 0); } while (0)
#define PG8_LDA(dst, b, h) do { _Pragma("unroll") for (int m = 0; m < 4; ++m) _Pragma("unroll") for (int k = 0; k < 2; ++k) dst[m][k] = *(const PG8_LAS bf16x8*)(lds + PG8_SA(b, h) + aoff + m * 2048 + k * 1024); } while (0)
#define PG8_LDB(dst, b, h) do { _Pragma("unroll") for (int n = 0; n < 2; ++n) _Pragma("unroll") for (int k = 0; k < 2; ++k) dst[n][k] = *(const PG8_LAS bf16x8*)(lds + PG8_SB(b, h) + boff + n * 2048 + k * 1024); } while (0)
#define PG8_MMA(ai, bj, At, Bt) do { __builtin_amdgcn_s_setprio(1); _Pragma("unroll") for (int m = 0; m < 4; ++m) _Pragma("unroll") for (int n = 0; n < 2; ++n) _Pragma("unroll") for (int k = 0; k < 2; ++k) \
        acc[ai][bj][m][n] = __builtin_amdgcn_mfma_f32_16x16x32_bf16(Bt[n][k], At[m][k], acc[ai][bj][m][n], 0, 0, 0); __builtin_amdgcn_s_setprio(0); } while (0)
#define PG8_WAIT_V(n) asm volatile("s_waitcnt vmcnt(" #n ")" ::: "memory")
#define PG8_WAIT_L(n) asm volatile("s_waitcnt lgkmcnt(" #n ")" ::: "memory")
#define PG8_BAR __builtin_amdgcn_s_barrier()
#define PG8_SCHED __builtin_amdgcn_sched_barrier(0)
    Unit cur, nxt; int ui = 0;
    if (!S.next(0, cur)) return;
    f32x4 acc[2][2][4][2];
#pragma unroll
    for (int a = 0; a < 2; ++a)
#pragma unroll
        for (int b = 0; b < 2; ++b)
#pragma unroll
            for (int m = 0; m < 4; ++m)
#pragma unroll
                for (int n = 0; n < 2; ++n) acc[a][b][m][n] = (f32x4){0.f, 0.f, 0.f, 0.f};
    bf16x8 At[4][2], B0[2][2], B1[2][2];
    const char* cA = (const char*)g.A + (size_t)cur.pm * tstep; const char* cB = (const char*)g.Bt + (size_t)cur.pn * tstep;
    S.a_ready(cur);
    if constexpr (SP2) {
        PG8_STAGE(PG8_SB(0, 0), cB, voffB); PG8_STAGE(PG8_SB(0, 1), cB + hstep, voffB); PG8_STAGE(PG8_SA(0, 0), cA, voffA); PG8_STAGE(PG8_SA(0, 1), cA + hstep, voffA);
        if (wr == 1) PG8_BAR;
        PG8_WAIT_V(2); PG8_BAR;
        PG8_STAGE(PG8_SB(1, 0), cB + kstep, voffB); PG8_STAGE(PG8_SA(1, 0), cA + kstep, voffA); PG8_STAGE(PG8_SB(1, 1), cB + hstep + kstep, voffB);
        PG8_WAIT_V(6); PG8_BAR;
    } else {
        PG8_STAGE(PG8_SB(0, 0), cB, voffB); PG8_STAGE(PG8_SA(0, 0), cA, voffA); PG8_STAGE(PG8_SB(0, 1), cB + hstep, voffB); PG8_STAGE(PG8_SA(0, 1), cA + hstep, voffA);
        if (wr == 1) PG8_BAR;
        PG8_WAIT_V(4); PG8_BAR;
        PG8_STAGE(PG8_SB(1, 0), cB + kstep, voffB); PG8_STAGE(PG8_SA(1, 0), cA + kstep, voffA); PG8_STAGE(PG8_SB(1, 1), cB + hstep + kstep, voffB);
        PG8_WAIT_V(6); PG8_BAR;
    }
    for (;;) {
        const bool has_next = S.next(ui + 1, nxt);
        const char* nA = has_next ? (const char*)g.A + (size_t)nxt.pm * tstep : cA; const char* nB = has_next ? (const char*)g.Bt + (size_t)nxt.pn * tstep : cB;
        for (int t = 0; t < nt; t += 2) {
            const bool last = (t == nt - 2);
            const char* a1 = cA + (size_t)(t + 1) * kstep;
            const char* a2 = last ? nA : cA + (size_t)(t + 2) * kstep; const char* b2 = last ? nB : cB + (size_t)(t + 2) * kstep;
            const char* a3 = a2 + kstep; const char* b3 = b2 + kstep;
            if (last && has_next) S.a_ready(nxt);
            if constexpr (SP2) {
            PG8_LDB(B0, 0, 0); PG8_LDB(B1, 0, 1); PG8_SCHED; PG8_LDA(At, 0, 0); PG8_STAGE(PG8_SA(1, 1), a1 + hstep, voffA);
            PG8_WAIT_V(8); PG8_WAIT_L(0); PG8_BAR; PG8_MMA(0, 0, At, B0); PG8_MMA(0, 1, At, B1); PG8_BAR; PG8_SCHED;
            PG8_LDA(At, 0, 1); PG8_STAGE(PG8_SB(0, 0), b2, voffB); PG8_STAGE(PG8_SB(0, 1), b2 + hstep, voffB); PG8_STAGE(PG8_SA(0, 0), a2, voffA);
            PG8_WAIT_V(8); PG8_WAIT_L(0); PG8_BAR; PG8_MMA(1, 0, At, B0); PG8_MMA(1, 1, At, B1); PG8_BAR; PG8_SCHED;
            PG8_LDB(B0, 1, 0); PG8_LDB(B1, 1, 1); PG8_SCHED; PG8_LDA(At, 1, 0); PG8_STAGE(PG8_SA(0, 1), a2 + hstep, voffA);
            PG8_WAIT_V(8); PG8_WAIT_L(0); PG8_BAR; PG8_MMA(0, 0, At, B0); PG8_MMA(0, 1, At, B1); PG8_BAR; PG8_SCHED;
            PG8_LDA(At, 1, 1); PG8_STAGE(PG8_SB(1, 0), b3, voffB); PG8_STAGE(PG8_SB(1, 1), b3 + hstep, voffB); PG8_STAGE(PG8_SA(1, 0), a3, voffA);
            PG8_WAIT_V(8); PG8_WAIT_L(0); PG8_BAR; PG8_MMA(1, 0, At, B0); PG8_MMA(1, 1, At, B1); PG8_BAR; PG8_SCHED;
            } else {
            PG8_LDB(B0, 0, 0); PG8_SCHED; PG8_LDA(At, 0, 0); PG8_STAGE(PG8_SA(1, 1), a1 + hstep, voffA);
            PG8_WAIT_L(8); PG8_BAR; PG8_WAIT_L(0); PG8_MMA(0, 0, At, B0); PG8_BAR; PG8_SCHED;
            PG8_LDB(B1, 0, 1); PG8_STAGE(PG8_SB(0, 0), b2, voffB);
            PG8_BAR; PG8_WAIT_L(0); PG8_MMA(0, 1, At, B1); PG8_BAR;
            PG8_LDA(At, 0, 1); PG8_STAGE(PG8_SA(0, 0), a2, voffA);
            PG8_BAR; PG8_WAIT_L(0); PG8_MMA(1, 0, At, B0); PG8_BAR; PG8_SCHED;
            PG8_STAGE(PG8_SB(0, 1), b2 + hstep, voffB);
            PG8_WAIT_V(6); PG8_BAR; PG8_MMA(1, 1, At, B1); PG8_BAR;
            PG8_LDB(B0, 1, 0); PG8_SCHED; PG8_LDA(At, 1, 0); PG8_STAGE(PG8_SA(0, 1), a2 + hstep, voffA);
            PG8_WAIT_L(8); PG8_BAR; PG8_WAIT_L(0); PG8_MMA(0, 0, At, B0); PG8_BAR; PG8_SCHED;
            PG8_LDB(B1, 1, 1); PG8_STAGE(PG8_SB(1, 0), b3, voffB);
            PG8_BAR; PG8_WAIT_L(0); PG8_MMA(0, 1, At, B1); PG8_BAR;
            PG8_LDA(At, 1, 1); PG8_STAGE(PG8_SA(1, 0), a3, voffA);
            PG8_BAR; PG8_WAIT_L(0); PG8_MMA(1, 0, At, B0); PG8_BAR; PG8_SCHED;
            PG8_STAGE(PG8_SB(1, 1), b3 + hstep, voffB);
            PG8_WAIT_V(6); PG8_BAR; PG8_MMA(1, 1, At, B1); PG8_BAR;
            }
        }
        if constexpr (ALIGN_EPI) { if (wr == 0) PG8_BAR; }
        if constexpr (!Epi::AFTER_DRAIN) { if constexpr (Epi::WANTS_NEXT) E(acc, cur, nxt, has_next, wr, wc, fr, fq); else E(acc, cur, wr, wc, fr, fq); S.done(cur); }
        if (!has_next) break;
#pragma unroll
        for (int a = 0; a < 2; ++a)
#pragma unroll
            for (int b = 0; b < 2; ++b)
#pragma unroll
                for (int m = 0; m < 4; ++m)
#pragma unroll
                    for (int n = 0; n < 2; ++n) acc[a][b][m][n] = (f32x4){0.f, 0.f, 0.f, 0.f};
        cur = nxt; cA = nA; cB = nB; ++ui;
        if constexpr (ALIGN_EPI) { if (wr == 1) PG8_BAR; }
    }
    PG8_WAIT_V(0);
    if constexpr (!ALIGN_EPI) { if (wr == 0) PG8_BAR; }
    PG8_BAR;
    if constexpr (Epi::AFTER_DRAIN) { E.fused(acc, cur, wr, wc, fr, fq, lds, wid, lane); S.done(cur); }
#undef PG8_SA
#undef PG8_SB
#undef PG8_STAGE
#undef PG8_LDA
#undef PG8_LDB
#undef PG8_MMA
#undef PG8_WAIT_V
#undef PG8_WAIT_L
#undef PG8_BAR
#undef PG8_SCHED
}
}

constexpr int NWAVES = 8, NTHREADS = 512;
constexpr int RING_BYTES = 131072, LDS_BYTES = 159744, LDSCTL_OFF = 158720;
struct Args { const float* in[26]; float* out; unsigned char* ws; int ph_lo, ph_hi, coop, pad; };
struct Ctx {
    const float* in[26]; float* out; unsigned char* ws; LAS unsigned char* lds; int tid, lane, wave, G, bid;
    float *PART, *BIASD, *CDEC, *DTRAW, *U0, *UL; bf16_t *WQKV, *WO, *WIN, *WOUT, *WUP, *WDN, *XB, *QKV, *AO, *ACT, *Z, *XBC, *ST, *HP, *XC;
};
enum { I_XP = 0, I_XS, I_CK, I_CV, I_SCONV, I_SSSM, I_SFFN, I_RELB, I_NMIX, I_NFFN, I_NFIN, I_WQKV, I_WO, I_SINK, I_WIN, I_CW, I_CB, I_DTB, I_ALOG, I_SD, I_SNORM, I_WOUT, I_WUP, I_FCW, I_FCB, I_WDN };

__device__ __forceinline__ int t5_bucket(int n) {
    if (n < 16) return n;
    int b = 16;
    b += (n >= 19); b += (n >= 21); b += (n >= 24); b += (n >= 27); b += (n >= 31); b += (n >= 35); b += (n >= 40); b += (n >= 46); b += (n >= 52); b += (n >= 59); b += (n >= 67); b += (n >= 77); b += (n >= 87); b += (n >= 99); b += (n >= 113);
    return b;
}

template <bool UPPERM> __device__ __forceinline__ void p0_transpose_item(const float* W, int K, int N, bf16_t* WT, const float* gain, LAS float* scr, int item, int lane) {
    const int nblk = N / 32, kb = item / nblk, nb = item % nblk, k0 = 64 * kb, n0 = 32 * nb;
    f32x4 ld[8];
#pragma unroll
    for (int i = 0; i < 8; ++i) ld[i] = *(const f32x4*)(W + (size_t)(k0 + 8 * i + (lane >> 3)) * N + n0 + 4 * (lane & 7));
#pragma unroll
    for (int i = 0; i < 8; ++i) { const int kk = 8 * i + (lane >> 3); f32x4 v = ld[i]; if (gain) v = v * gain[k0 + kk];
        LAS float* d = scr + kk * 33 + 4 * (lane & 7); d[0] = v.x; d[1] = v.y; d[2] = v.z; d[3] = v.w; }
    asm volatile("s_waitcnt lgkmcnt(0)" ::: "memory");
    const int c = lane & 7;
#pragma unroll
    for (int j = 0; j < 4; ++j) { const int n = (lane >> 3) + 8 * j; const LAS float* s = scr + (8 * c) * 33 + n;
        u32x4 o; o.x = pk2(s[0 * 33], s[1 * 33]); o.y = pk2(s[2 * 33], s[3 * 33]); o.z = pk2(s[4 * 33], s[5 * 33]); o.w = pk2(s[6 * 33], s[7 * 33]);
        int dr = n0 + n;
        if (UPPERM) dr = (dr < DFF) ? ((dr >> 7) * 256 + (dr & 127)) : (((dr - DFF) >> 7) * 256 + 128 + ((dr - DFF) & 127));
        *(u32x4*)(WT + (size_t)dr * K + k0 + 8 * c) = o; }
    asm volatile("s_waitcnt lgkmcnt(0)" ::: "memory");
}
template <int GRP> __device__ __forceinline__ void convert_group(const Ctx& C, int gw, int NGW) {
    LAS float* scr = (LAS float*)(C.lds + C.wave * 16384);
    constexpr int I0 = (DM / 64) * (NQKV / 32), I1 = (DM / 64) * (DM / 32), I2 = (DM / 64) * (NIN / 32), I3 = (DIN / 64) * (DM / 32), I4 = (DM / 64) * (NUP / 32), I5 = (DFF / 64) * (DM / 32);
    if (GRP == 0) for (int it = gw; it < I0; it += NGW) p0_transpose_item<false>(C.in[I_WQKV], DM, NQKV, C.WQKV, C.in[I_NMIX], scr, it, C.lane);
    if (GRP == 1) for (int it = gw; it < I1 + I4; it += NGW) {
        if (it < I1) p0_transpose_item<false>(C.in[I_WO], DM, DM, C.WO, nullptr, scr, it, C.lane);
        else p0_transpose_item<true>(C.in[I_WUP], DM, NUP, C.WUP, C.in[I_NFFN], scr, it - I1, C.lane); }
    if (GRP == 2) {
        for (int it = gw; it < I5 + I2; it += NGW) {
            if (it < I5) p0_transpose_item<false>(C.in[I_WDN], DFF, DM, C.WDN, nullptr, scr, it, C.lane);
            else p0_transpose_item<false>(C.in[I_WIN], DM, NIN, C.WIN, C.in[I_NMIX] + DM, scr, it - I5, C.lane); }
        u32x4* z = (u32x4*)(C.WIN + (size_t)NIN * DM);
        for (int i = gw * 64 + C.lane; i < (NINP - NIN) * DM / 8; i += NGW * 64) z[i] = (u32x4){0u, 0u, 0u, 0u};
    }
    if (GRP == 3) for (int it = gw; it < I3 + I4; it += NGW) {
        if (it < I3) p0_transpose_item<false>(C.in[I_WOUT], DIN, DM, C.WOUT, C.in[I_SNORM], scr, it, C.lane);
        else p0_transpose_item<true>(C.in[I_WUP] + (size_t)DM * NUP, DM, NUP, C.WUP + (size_t)NUP * DM, C.in[I_NFFN] + DM, scr, it - I3, C.lane); }
    if (GRP == 4) for (int it = gw; it < I5; it += NGW) p0_transpose_item<false>(C.in[I_WDN] + (size_t)DFF * DM, DFF, DM, C.WDN + (size_t)DM * DFF, nullptr, scr, it, C.lane);
}
template <int GRP> __device__ __forceinline__ void convert_in_tail(const Ctx& C, int nwg) {
    const int r = nwg % C.G;
    if (C.bid >= r) convert_group<GRP>(C, (C.bid - r) * NWAVES + C.wave, (C.G - r) * NWAVES);
    __syncthreads();
}
__device__ __forceinline__ void phase_prologue(const Ctx& C) {
    const int gw = C.bid * NWAVES + C.wave, NGW = C.G * NWAVES;
    convert_group<0>(C, gw, NGW);
    for (int m = gw; m < MT; m += NGW) {
        const float* xrow = (m < MP) ? C.in[I_XP] + (size_t)m * DM : C.in[I_XS] + (size_t)(m - MP) * DM;
        const f32x4* xr = (const f32x4*)xrow + 2 * C.lane; f32x4 v[4]; float s = 0.f;
#pragma unroll
        for (int j = 0; j < 4; ++j) { v[j] = xr[128 * (j >> 1) + (j & 1)]; s += (v[j].x * v[j].x + v[j].y * v[j].y) + (v[j].z * v[j].z + v[j].w * v[j].w); }
        s = wave_sum(s);
        u32x4* o16 = (u32x4*)(C.XB + (size_t)m * DM) + C.lane;
#pragma unroll
        for (int j = 0; j < 2; ++j) { u32x4 w; w.x = pk2(v[2 * j].x, v[2 * j].y); w.y = pk2(v[2 * j].z, v[2 * j].w); w.z = pk2(v[2 * j + 1].x, v[2 * j + 1].y); w.w = pk2(v[2 * j + 1].z, v[2 * j + 1].w); o16[64 * j] = w; }
        if (C.lane < 16) C.PART[(size_t)m * 16 + C.lane] = (C.lane == 0) ? s : 0.f;
    }
    { const int gt = C.bid * NTHREADS + C.tid; if (gt < 16 * 128) { const int h = gt >> 7, d = gt & 127; C.BIASD[gt] = C.in[I_RELB][t5_bucket(d) * 16 + h] * LOG2E; } }
}

#define MFMA32(a, b, c) __builtin_amdgcn_mfma_f32_32x32x16_bf16((a), (b), (c), 0, 0, 0)
typedef short v4i16_t __attribute__((ext_vector_type(4)));
__device__ __forceinline__ s16x4 lds_tr4(const LAS bf16_t* p) { return __builtin_bit_cast(s16x4, __builtin_amdgcn_ds_read_tr16_b64_v4i16((LAS v4i16_t*)p)); }
__device__ __forceinline__ bf16x8 cat8(s16x4 a, s16x4 b) { return (bf16x8){a[0], a[1], a[2], a[3], b[0], b[1], b[2], b[3]}; }
__device__ __forceinline__ f32x16 zero16() { f32x16 z; for (int i = 0; i < 16; ++i) z[i] = 0.f; return z; }

__device__ __forceinline__ void attn_prompt_unit(const Ctx& C, int b, int c, int g) {
    LAS bf16_t* Ks = (LAS bf16_t*)C.lds;
    LAS bf16_t* Vt = (LAS bf16_t*)(C.lds + 36864);
    LAS float* Bd = (LAS float*)(C.lds + 36864 + 33792);
    const int tid = C.tid, lane = C.lane, w = C.wave;
    const bf16_t* qbase = C.QKV + (size_t)(b * SEQ + c * 128 + (w & 1) * 64 + (lane & 31)) * NQKV + (g * 4 + (w >> 1)) * 64 + 8 * (lane >> 5);
    bf16x8 qn[4];
#pragma unroll
    for (int s = 0; s < 4; ++s) qn[s] = *(const bf16x8*)(qbase + 16 * s);
#pragma unroll
    for (int i = 0; i < 4; ++i) {
        const int id = i * NTHREADS + tid, row = id >> 3, ch = id & 7, kpos = (c - 1) * 128 + row;
        u32x4 kv = (u32x4){0u, 0u, 0u, 0u}, vv = (u32x4){0u, 0u, 0u, 0u};
        if (kpos >= 0) { const bf16_t* src = C.QKV + (size_t)(b * SEQ + kpos) * NQKV + 1024 + g * 64 + ch * 8; kv = *(const u32x4*)src; vv = *(const u32x4*)(src + 256); }
        *(LAS u32x4*)(Ks + row * 72 + ch * 8) = kv;
        const int prow = (row & ~15) | ((row & 3) + 4 * ((row >> 3) & 1) + 8 * ((row >> 2) & 1));
        LAS bf16_t* vd = Vt + (ch * 8) * 264 + prow;
        vd[0 * 264] = (bf16_t)(vv.x & 0xffffu); vd[1 * 264] = (bf16_t)(vv.x >> 16); vd[2 * 264] = (bf16_t)(vv.y & 0xffffu); vd[3 * 264] = (bf16_t)(vv.y >> 16);
        vd[4 * 264] = (bf16_t)(vv.z & 0xffffu); vd[5 * 264] = (bf16_t)(vv.z >> 16); vd[6 * 264] = (bf16_t)(vv.w & 0xffffu); vd[7 * 264] = (bf16_t)(vv.w >> 16);
    }
    Bd[tid] = C.BIASD[(g * 4 + (tid >> 7)) * 128 + (tid & 127)];
    __syncthreads();
    const int r = w >> 1, ph = w & 1, hh = g * 4 + r, ql = lane & 31, hi = lane >> 5;
    const float sink2 = C.in[I_SINK][hh] * LOG2E;
    const int jmin = (c == 0) ? 128 : 0;
    for (int qg = 0; qg < 2; ++qg) {
        const int q0 = ph * 64 + qg * 32, qi = q0 + ql, t0 = q0 >> 5;
        const size_t qrow = (size_t)(b * SEQ + c * 128 + qi);
        bf16x8 qf[4];
#pragma unroll
        for (int s = 0; s < 4; ++s) qf[s] = qn[s];
        if (qg == 0) {
#pragma unroll
            for (int s = 0; s < 4; ++s) qn[s] = *(const bf16x8*)(qbase + (size_t)32 * NQKV + 16 * s); }
        f32x16 S[5];
#pragma unroll
        for (int kk = 0; kk < 5; ++kk) {
            S[kk] = zero16();
#pragma unroll
            for (int s = 0; s < 4; ++s) { const bf16x8 kf = *(const LAS bf16x8*)(Ks + (32 * (t0 + kk) + ql) * 72 + 16 * s + 8 * hi); S[kk] = MFMA32(kf, qf[s], S[kk]); }
        }
        float mx = sink2; const int dbase = qi + 128 - 32 * t0;
#pragma unroll
        for (int kk = 0; kk < 5; ++kk)
#pragma unroll
            for (int rr = 0; rr < 16; ++rr) {
                const int jl = 32 * kk + crow(rr, hi), d = dbase - jl, j = 32 * t0 + jl;
                float v = S[kk][rr] * (0.125f * LOG2E) + Bd[r * 128 + (d & 127)];
                if (kk == 0 || kk == 4 || c == 0) { const bool ok = (d >= 0) && (d < 128) && (j >= jmin); v = ok ? v : -INFINITY; }
                S[kk][rr] = v; mx = fmaxf(mx, v);
            }
        mx = fmaxf(mx, __shfl_xor(mx, 32));
        float l = 0.f;
#pragma unroll
        for (int kk = 0; kk < 5; ++kk)
#pragma unroll
            for (int rr = 0; rr < 16; ++rr) { const float p = __builtin_amdgcn_exp2f(S[kk][rr] - mx); S[kk][rr] = p; l += p; }
        l += __shfl_xor(l, 32); l += __builtin_amdgcn_exp2f(sink2 - mx);
        const float inv = 1.0f / l;
        f32x16 O[2]; O[0] = zero16(); O[1] = zero16();
#pragma unroll
        for (int kk = 0; kk < 5; ++kk)
#pragma unroll
            for (int ks = 0; ks < 2; ++ks) {
                u32x4 pw; pw.x = pk2(S[kk][8 * ks + 0], S[kk][8 * ks + 1]); pw.y = pk2(S[kk][8 * ks + 2], S[kk][8 * ks + 3]); pw.z = pk2(S[kk][8 * ks + 4], S[kk][8 * ks + 5]); pw.w = pk2(S[kk][8 * ks + 6], S[kk][8 * ks + 7]);
                const bf16x8 pf = __builtin_bit_cast(bf16x8, pw);
#pragma unroll
                for (int dt = 0; dt < 2; ++dt) { const bf16x8 vf = *(const LAS bf16x8*)(Vt + (32 * dt + ql) * 264 + 32 * (t0 + kk) + 16 * ks + 8 * hi); O[dt] = MFMA32(vf, pf, O[dt]); }
            }
#pragma unroll
        for (int dt = 0; dt < 2; ++dt)
#pragma unroll
            for (int q4 = 0; q4 < 4; ++q4) {
                u32x2 wv; wv.x = pk2(O[dt][4 * q4] * inv, O[dt][4 * q4 + 1] * inv); wv.y = pk2(O[dt][4 * q4 + 2] * inv, O[dt][4 * q4 + 3] * inv);
                *(u32x2*)(C.AO + qrow * DM + hh * 64 + 32 * dt + 8 * q4 + 4 * hi) = wv;
            }
    }
    if (c == NCHUNK - 1) {
#pragma unroll
        for (int i = 0; i < 2; ++i) {
            const int id = i * NTHREADS + tid, wq = id >> 3, ch = id & 7;
            const bf16_t* src = C.QKV + (size_t)(b * SEQ + SEQ - 128 + wq) * NQKV + 1024 + g * 64 + ch * 8;
            float kf[8], vf[8]; unpack8(*(const u32x4*)src, kf); unpack8(*(const u32x4*)(src + 256), vf);
            float* ok = C.out + O_PK + ((size_t)(b * 128 + wq) * 4 + g) * 64 + ch * 8; float* ov = C.out + O_PV + ((size_t)(b * 128 + wq) * 4 + g) * 64 + ch * 8;
            *(f32x4*)ok = (f32x4){kf[0], kf[1], kf[2], kf[3]}; *(f32x4*)(ok + 4) = (f32x4){kf[4], kf[5], kf[6], kf[7]};
            *(f32x4*)ov = (f32x4){vf[0], vf[1], vf[2], vf[3]}; *(f32x4*)(ov + 4) = (f32x4){vf[4], vf[5], vf[6], vf[7]};
        }
    }
    __syncthreads();
}
__device__ __forceinline__ void attn_sample_unit(const Ctx& C, int b, int g) {
    constexpr int KP = 68;
    LAS float* Kc = (LAS float*)C.lds;
    LAS float* Vc = Kc + 132 * KP;
    LAS float* Qs = Vc + 132 * KP;
    LAS float* Ps = Qs + 16 * KP;
    LAS float* Bd2 = Ps + 16 * 132;
    LAS float* Po = Bd2 + 512;
    const int tid = C.tid, lane = C.lane, w = C.wave;
    const float* ck = C.in[I_CK]; const float* cv = C.in[I_CV];
#pragma unroll
    for (int i = 0; i < 4; ++i) {
        const int id = i * NTHREADS + tid, wq = id >> 4, ch = id & 15; const size_t off = ((size_t)(b * 128 + wq) * 4 + g) * 64 + ch * 4;
        const f32x4 kv = *(const f32x4*)(ck + off), vv = *(const f32x4*)(cv + off);
        *(LAS f32x4*)(Kc + wq * KP + ch * 4) = kv; *(LAS f32x4*)(Vc + wq * KP + ch * 4) = vv;
        if (wq >= 4) { const size_t oo = ((size_t)(b * 128 + wq - 4) * 4 + g) * 64 + ch * 4; *(f32x4*)(C.out + O_SK + oo) = kv; *(f32x4*)(C.out + O_SV + oo) = vv; }
    }
    { const int isv = tid >> 8, s = (tid >> 6) & 3, d = tid & 63;
      const float val = bf2f(C.QKV[(size_t)(MP + b * 4 + s) * NQKV + 1024 + isv * 256 + g * 64 + d]);
      (isv ? Vc : Kc)[(128 + s) * KP + d] = val;
      C.out[(isv ? O_SV : O_SK) + ((size_t)(b * 128 + 124 + s) * 4 + g) * 64 + d] = val; }
#pragma unroll
    for (int i = 0; i < 2; ++i) { const int id = i * NTHREADS + tid, qr = id >> 6, d = id & 63, r = qr >> 2, s = qr & 3;
        Qs[qr * KP + d] = bf2f(C.QKV[(size_t)(MP + b * 4 + s) * NQKV + (g * 4 + r) * 64 + d]); }
    Bd2[tid] = C.BIASD[(g * 4 + (tid >> 7)) * 128 + (tid & 127)];
    __syncthreads();
    for (int kb = 0; kb < 132; kb += 128) {
        const int key = kb + (tid >> 2), r = tid & 3;
        if (key < 132) {
            f32x4 acc = (f32x4){0.f, 0.f, 0.f, 0.f};
#pragma unroll 4
            for (int d4 = 0; d4 < 16; ++d4) {
                const f32x4 k4 = *(const LAS f32x4*)(Kc + key * KP + 4 * d4);
#pragma unroll
                for (int s = 0; s < 4; ++s) { const f32x4 q4 = *(const LAS f32x4*)(Qs + (r * 4 + s) * KP + 4 * d4); acc[s] += (k4.x * q4.x + k4.y * q4.y) + (k4.z * q4.z + k4.w * q4.w); }
            }
#pragma unroll
            for (int s = 0; s < 4; ++s) { const int dist = 128 + s - key; const bool ok = (dist >= 0) && (dist < 128);
                Ps[(r * 4 + s) * 132 + key] = ok ? acc[s] * (0.125f * LOG2E) + Bd2[r * 128 + (dist & 127)] : -INFINITY; }
        }
    }
    __syncthreads();
#pragma unroll
    for (int qq = 0; qq < 2; ++qq) {
        const int qr = 2 * w + qq, r = qr >> 2; const float sink2 = C.in[I_SINK][g * 4 + r] * LOG2E;
        LAS float* pr = Ps + qr * 132;
        const float v0 = pr[lane], v1 = pr[64 + lane], v2 = (lane < 4) ? pr[128 + lane] : -INFINITY;
        const float mx = fmaxf(wave_max(fmaxf(fmaxf(v0, v1), v2)), sink2);
        const float p0 = __builtin_amdgcn_exp2f(v0 - mx), p1 = __builtin_amdgcn_exp2f(v1 - mx), p2 = __builtin_amdgcn_exp2f(v2 - mx);
        const float l = wave_sum(p0 + p1 + p2) + __builtin_amdgcn_exp2f(sink2 - mx), inv = 1.0f / l;
        pr[lane] = p0 * inv; pr[64 + lane] = p1 * inv; if (lane < 4) pr[128 + lane] = p2 * inv;
    }
    __syncthreads();
    { const int kg = tid >> 7, q2 = (tid >> 4) & 7, dq = tid & 15; f32x4 o0 = (f32x4){0.f, 0.f, 0.f, 0.f}, o1 = o0;
      const LAS float* pa = Ps + (2 * q2) * 132 + kg * 33; const LAS float* vp = Vc + (kg * 33) * KP + 4 * dq;
#pragma unroll 3
      for (int k = 0; k < 33; ++k) { const f32x4 v4 = *(const LAS f32x4*)(vp + k * KP); const float pA = pa[k], pB = pa[132 + k]; o0 += v4 * pA; o1 += v4 * pB; }
      *(LAS f32x4*)(Po + ((kg * 16 + 2 * q2) * 64) + 4 * dq) = o0; *(LAS f32x4*)(Po + ((kg * 16 + 2 * q2 + 1) * 64) + 4 * dq) = o1; }
    __syncthreads();
    { const int qr = tid >> 5, d = (tid & 31) * 2, r = qr >> 2, s = qr & 3; const LAS float* pp = Po + qr * 64 + d;
      const float o0 = (pp[0] + pp[1024]) + (pp[2048] + pp[3072]), o1 = (pp[1] + pp[1025]) + (pp[2049] + pp[3073]);
      *(unsigned*)(C.AO + (size_t)(MP + b * 4 + s) * DM + (g * 4 + r) * 64 + d) = pk2(o0, o1); }
    __syncthreads();
}
__device__ __forceinline__ void phase_attention(const Ctx& C) {
    for (int u = C.bid; u < 1024; u += C.G) {
        if (u < 512) attn_prompt_unit(C, u >> 7, (u >> 2) & 31, u & 3);
        else attn_sample_unit(C, (u - 512) >> 2, u & 3);
    }
}

__device__ __forceinline__ void ffn_fixup_tile(const Ctx& C, int layer, int pm) {
    if ((pm & 15) != 0 && pm < MP / 256) {
        const float* cw = C.in[I_FCW] + (size_t)layer * 3 * NUP; const float* cb = C.in[I_FCB] + (size_t)layer * NUP;
        int t_ = (int)threadIdx.x; asm volatile("" : "+v"(t_));
        for (int id = t_; id < 2 * (DFF / 4); id += NTHREADS) {
            const int k = (id >= DFF / 4) ? 1 : 0, ch = 4 * (id - k * (DFF / 4));
            const float* u0 = C.U0 + (size_t)(pm * 2) * NUP + ch; const float* ul = C.UL + (size_t)((pm - 1) * 2) * NUP + ch;
            const f32x4 ca = *(const f32x4*)(u0 + k * NUP), cv = *(const f32x4*)(u0 + k * NUP + DFF);
            const f32x4 p1a = k ? *(const f32x4*)u0 : *(const f32x4*)(ul + NUP), p1b = k ? *(const f32x4*)(u0 + DFF) : *(const f32x4*)(ul + NUP + DFF);
            const f32x4 p2a = k ? *(const f32x4*)(ul + NUP) : *(const f32x4*)ul, p2b = k ? *(const f32x4*)(ul + NUP + DFF) : *(const f32x4*)(ul + DFF);
            const f32x4 ya = *(const f32x4*)(cb + ch) + *(const f32x4*)(cw + ch) * p2a + *(const f32x4*)(cw + NUP + ch) * p1a + *(const f32x4*)(cw + 2 * NUP + ch) * ca;
            const f32x4 yb = *(const f32x4*)(cb + DFF + ch) + *(const f32x4*)(cw + DFF + ch) * p2b + *(const f32x4*)(cw + NUP + DFF + ch) * p1b + *(const f32x4*)(cw + 2 * NUP + DFF + ch) * cv;
            u32x2 ov; ov.x = pk2(silu_f(ya[0]) * yb[0], silu_f(ya[1]) * yb[1]); ov.y = pk2(silu_f(ya[2]) * yb[2], silu_f(ya[3]) * yb[3]);
            *(u32x2*)(C.ACT + (size_t)(pm * 256 + k) * DFF + ch) = ov;
        }
    }
    asm volatile("s_waitcnt vmcnt(0)" ::: "memory");
    __syncthreads();
}

__device__ __forceinline__ void phase_final_norm(const Ctx& C) {
    const int gw = C.bid * NWAVES + C.wave, NGW = C.G * NWAVES; const f32x4* gp = (const f32x4*)C.in[I_NFIN] + 2 * C.lane;
    f32x4 gv[4];
#pragma unroll
    for (int j = 0; j < 4; ++j) gv[j] = gp[128 * (j >> 1) + (j & 1)];
    for (int m = gw; m < MT; m += NGW) {
        const float rs = row_rstd(C.PART, m);
        const u32x4* xr = (const u32x4*)(C.XB + (size_t)m * DM) + C.lane;
        f32x4* o = (f32x4*)(C.out + (m < MP ? O_YP + (size_t)m * DM : O_YS + (size_t)(m - MP) * DM)) + 2 * C.lane;
#pragma unroll
        for (int j = 0; j < 2; ++j) { float f[8]; unpack8(xr[64 * j], f);
            o[128 * j] = (f32x4){f[0], f[1], f[2], f[3]} * rs * gv[2 * j]; o[128 * j + 1] = (f32x4){f[4], f[5], f[6], f[7]} * rs * gv[2 * j + 1]; }
    }
}

__device__ __forceinline__ float softplus_f(float x) { return (x > 20.f) ? x : log1pf(__expf(x)); }
template <int NCH> struct ConvRaw { u32x4 h[3]; u32x4 raw[128 * NCH / NTHREADS]; };
template <int NCH> __device__ __forceinline__ void conv_load(const Ctx& C, size_t row0, int t0, int c0, ConvRaw<NCH>& R) {
    constexpr int H = 128 * NCH / NTHREADS;
    int tl = C.tid; asm volatile("" : "+v"(tl));
    const int ch = tl % NCH, r0 = (tl / NCH) * H, cc = c0 + ch * 8;
    const bf16_t* src = C.XBC + (row0 + r0) * NCONV + cc;
    if (t0 + r0 >= 3) { R.h[0] = *(const u32x4*)(src - 3 * NCONV); R.h[1] = *(const u32x4*)(src - 2 * NCONV); R.h[2] = *(const u32x4*)(src - NCONV); }
    else { R.h[0] = (u32x4){0u, 0u, 0u, 0u}; R.h[1] = R.h[0]; R.h[2] = R.h[0]; }
#pragma unroll
    for (int i = 0; i < H; ++i) R.raw[i] = *(const u32x4*)(src + (size_t)i * NCONV);
}
template <int NCH> __device__ __forceinline__ void conv_compute(const Ctx& C, int c0, const ConvRaw<NCH>& R, u32x4 (&outv)[128 * NCH / NTHREADS], float* state) {
    constexpr int H = 128 * NCH / NTHREADS;
    int tl = C.tid; asm volatile("" : "+v"(tl));
    const int ch = tl % NCH, r0 = (tl / NCH) * H, cc = c0 + ch * 8;
    const float* cw = C.in[I_CW] + cc; const float* cb = C.in[I_CB] + cc;
    float w[4][8], bv[8];
#pragma unroll
    for (int k = 0; k < 4; ++k) { const f32x4 a = *(const f32x4*)(cw + k * NCONV), b = *(const f32x4*)(cw + k * NCONV + 4); w[k][0] = a.x; w[k][1] = a.y; w[k][2] = a.z; w[k][3] = a.w; w[k][4] = b.x; w[k][5] = b.y; w[k][6] = b.z; w[k][7] = b.w; }
    { const f32x4 a = *(const f32x4*)cb, b = *(const f32x4*)(cb + 4); bv[0] = a.x; bv[1] = a.y; bv[2] = a.z; bv[3] = a.w; bv[4] = b.x; bv[5] = b.y; bv[6] = b.z; bv[7] = b.w; }
    float a3[8], a2[8], a1[8]; unpack8(R.h[0], a3); unpack8(R.h[1], a2); unpack8(R.h[2], a1);
#pragma unroll
    for (int i = 0; i < H; ++i) {
        float cur[8], o[8]; unpack8(R.raw[i], cur);
#pragma unroll
        for (int e = 0; e < 8; ++e) o[e] = silu_f(bv[e] + w[0][e] * a3[e] + w[1][e] * a2[e] + w[2][e] * a1[e] + w[3][e] * cur[e]);
        outv[i] = pack8(o);
        if (state != nullptr && r0 + i >= 125) { float* op = state + (size_t)(r0 + i - 125) * NCONV + cc; *(f32x4*)op = (f32x4){cur[0], cur[1], cur[2], cur[3]}; *(f32x4*)(op + 4) = (f32x4){cur[4], cur[5], cur[6], cur[7]}; }
#pragma unroll
        for (int e = 0; e < 8; ++e) { a3[e] = a2[e]; a2[e] = a1[e]; a1[e] = cur[e]; }
    }
}
template <int NCH> __device__ __forceinline__ void conv_rows(const Ctx& C, size_t row0, int t0, int c0, u32x4 (&outv)[128 * NCH / NTHREADS], float* state) {
    ConvRaw<NCH> R; conv_load<NCH>(C, row0, t0, c0, R); conv_compute<NCH>(C, c0, R, outv, state);
}
__device__ __forceinline__ void chunk_scan_v(float r0, float r1, float dtb, float A, int lane, float& cs0, float& cs1, float& d0, float& d1, float& tot);
__device__ __forceinline__ void chunk_scan(const float* dtp  , float dtb, float A, int lane, float& cs0, float& cs1, float& d0, float& d1, float& tot) {
    chunk_scan_v(dtp[(size_t)(2 * lane) * 32], dtp[(size_t)(2 * lane + 1) * 32], dtb, A, lane, cs0, cs1, d0, d1, tot);
}
__device__ __forceinline__ void chunk_scan_v(float r0, float r1, float dtb, float A, int lane, float& cs0, float& cs1, float& d0, float& d1, float& tot) {
    d0 = softplus_f(r0 + dtb); d1 = softplus_f(r1 + dtb);
    const float a0 = d0 * A, a1 = d1 * A; float inc = a0 + a1;
#pragma unroll
    for (int o = 1; o < 64; o <<= 1) { const float v = __shfl_up(inc, o); if (lane >= o) inc += v; }
    cs1 = inc; cs0 = inc - a1; tot = __shfl(inc, 63);
}
constexpr int XP = 272, BP = 144;
__device__ __forceinline__ void ssd_states_unit(const Ctx& C, int rb, int g) {
    const int w = C.wave, lane = C.lane, r = w >> 1, phalf = w & 1, h = g * 4 + r, ql = lane & 31, hi = lane >> 5, li = lane & 15, gi = (lane >> 4) & 1;
    LAS bf16_t* Xn = (LAS bf16_t*)C.lds;
    LAS bf16_t* Bn = (LAS bf16_t*)(C.lds + 128 * XP * 2);
    LAS float* F = (LAS float*)(C.lds + 128 * XP * 2 + 128 * BP * 2) + w * 128;
    const size_t row0 = (size_t)rb * 128;
    {   const int t0 = (rb & 31) * 128; float* sto = ((rb & 31) == 31) ? C.out + O_PCONV + (size_t)(rb >> 5) * 3 * NCONV : nullptr;
        u32x4 xv[8]; conv_rows<32>(C, row0, t0, g * 256, xv, sto);
        { const int ch = C.tid & 31, r0 = (C.tid >> 5) * 8;
#pragma unroll
          for (int i = 0; i < 8; ++i) { *(LAS u32x4*)(Xn + (r0 + i) * XP + ch * 8) = xv[i]; *(u32x4*)(C.XC + (row0 + r0 + i) * 3072 + g * 256 + ch * 8) = xv[i]; } }
        u32x4 bvv[4]; conv_rows<16>(C, row0, t0, 2048 + g * 128, bvv, sto);
        { const int ch = C.tid & 15, r0 = (C.tid >> 4) * 4;
#pragma unroll
          for (int i = 0; i < 4; ++i) { *(LAS u32x4*)(Bn + (r0 + i) * BP + ch * 8) = bvv[i]; *(u32x4*)(C.XC + (row0 + r0 + i) * 3072 + 2048 + g * 128 + ch * 8) = bvv[i]; } } }
    const float A = -__expf(C.in[I_ALOG][h]);
    float cs0, cs1, d0, d1, tot; chunk_scan(C.DTRAW + (size_t)(rb * 128) * 32 + h, C.in[I_DTB][h], A, lane, cs0, cs1, d0, d1, tot);
    F[2 * lane] = __expf(tot - cs0) * d0; F[2 * lane + 1] = __expf(tot - cs1) * d1;
    if (phalf == 0 && lane == 0) C.CDEC[rb * 32 + h] = __expf(tot);
    __syncthreads();
    f32x16 acc[4];
#pragma unroll
    for (int nt = 0; nt < 4; ++nt) acc[nt] = zero16();
    const LAS bf16_t* xb = Xn + (8 * hi + (li >> 2)) * XP + r * 64 + phalf * 32 + 16 * gi + 4 * (li & 3);
    const LAS bf16_t* bb = Bn + (8 * hi + (li >> 2)) * BP + 16 * gi + 4 * (li & 3);
#pragma unroll
    for (int s = 0; s < 8; ++s) {
        const s16x4 x0 = lds_tr4(xb + 16 * s * XP), x1 = lds_tr4(xb + (16 * s + 4) * XP);
        const f32x4 f0 = *(const LAS f32x4*)(F + 16 * s + 8 * hi), f1 = *(const LAS f32x4*)(F + 16 * s + 8 * hi + 4);
        u32x4 aw; aw.x = pk2(bf2f((unsigned short)x0[0]) * f0.x, bf2f((unsigned short)x0[1]) * f0.y); aw.y = pk2(bf2f((unsigned short)x0[2]) * f0.z, bf2f((unsigned short)x0[3]) * f0.w);
        aw.z = pk2(bf2f((unsigned short)x1[0]) * f1.x, bf2f((unsigned short)x1[1]) * f1.y); aw.w = pk2(bf2f((unsigned short)x1[2]) * f1.z, bf2f((unsigned short)x1[3]) * f1.w);
        const bf16x8 af = __builtin_bit_cast(bf16x8, aw);
#pragma unroll
        for (int nt = 0; nt < 4; ++nt) { const bf16x8 bfr = cat8(lds_tr4(bb + 16 * s * BP + nt * 32), lds_tr4(bb + (16 * s + 4) * BP + nt * 32)); acc[nt] = MFMA32(af, bfr, acc[nt]); }
    }
    bf16_t* stp = C.ST + ((size_t)(rb * 32 + h) * 64 + phalf * 32) * 128 + ql;
#pragma unroll
    for (int nt = 0; nt < 4; ++nt)
#pragma unroll
        for (int rg = 0; rg < 16; ++rg) stp[(size_t)crow(rg, hi) * 128 + nt * 32] = (bf16_t)(pk2(acc[nt][rg], 0.f) & 0xffffu);
    __syncthreads();
}
__device__ __forceinline__ void ssd_sample_unit(const Ctx& C, int b, int g) {
    LAS float* Bs = (LAS float*)C.lds;
    LAS float* Cs = Bs + 512;
    LAS float* Xs = Cs + 512;
    LAS float* Dts = Xs + 1024;
    LAS float* Css = Dts + 16;
    LAS float* Cbm = Css + 16;
    LAS float* Yt = Cbm + 16;
    LAS float* Red = Yt + 1024;
    const int tid = C.tid, lane = C.lane, w = C.wave; const size_t m0 = (size_t)MP + b * 4;
    const int p = tid >> 3, ns = tid & 7;
    f32x4 hv[4][4];
#pragma unroll
    for (int hl = 0; hl < 4; ++hl) { const float* sin = C.in[I_SSSM] + ((size_t)(b * 32 + g * 4 + hl) * 64 + p) * 128 + ns * 4;
#pragma unroll
        for (int k = 0; k < 4; ++k) hv[hl][k] = __builtin_nontemporal_load((const f32x4*)(sin + 32 * k)); }
    __syncthreads();
    if (tid < 64) {
        const int cc = (tid < 32) ? g * 256 + 8 * tid : (tid < 48) ? 2048 + g * 128 + 8 * (tid - 32) : 3072 + g * 128 + 8 * (tid - 48);
        const float* stp = C.in[I_SCONV] + (size_t)b * 3 * NCONV + cc; const bf16_t* xr = C.XBC + m0 * NCONV + cc; const float* cw = C.in[I_CW] + cc; const float* cb = C.in[I_CB] + cc;
        f32x4 sv[3][2], wv[4][2], bv[2]; u32x4 rw[4];
#pragma unroll
        for (int k = 0; k < 3; ++k) { sv[k][0] = *(const f32x4*)(stp + k * NCONV); sv[k][1] = *(const f32x4*)(stp + k * NCONV + 4); }
#pragma unroll
        for (int k = 0; k < 4; ++k) { rw[k] = *(const u32x4*)(xr + (size_t)k * NCONV); wv[k][0] = *(const f32x4*)(cw + k * NCONV); wv[k][1] = *(const f32x4*)(cw + k * NCONV + 4); }
        bv[0] = *(const f32x4*)cb; bv[1] = *(const f32x4*)(cb + 4);
        float xp[7][8];
#pragma unroll
        for (int k = 0; k < 3; ++k) { xp[k][0] = sv[k][0].x; xp[k][1] = sv[k][0].y; xp[k][2] = sv[k][0].z; xp[k][3] = sv[k][0].w; xp[k][4] = sv[k][1].x; xp[k][5] = sv[k][1].y; xp[k][6] = sv[k][1].z; xp[k][7] = sv[k][1].w; }
#pragma unroll
        for (int k = 0; k < 4; ++k) unpack8(rw[k], xp[3 + k]);
#pragma unroll
        for (int t = 0; t < 4; ++t) {
            float o[8];
#pragma unroll
            for (int e = 0; e < 8; ++e) { float y = (e < 4) ? bv[0][e] : bv[1][e - 4];
#pragma unroll
                for (int k = 0; k < 4; ++k) y += ((e < 4) ? wv[k][0][e] : wv[k][1][e - 4]) * xp[t + k][e];
                o[e] = silu_f(y); }
            LAS float* dst = (tid < 32) ? Xs + ((tid >> 3) * 4 + t) * 64 + 8 * (tid & 7) : (tid < 48) ? Bs + t * 128 + 8 * (tid - 32) : Cs + t * 128 + 8 * (tid - 48);
#pragma unroll
            for (int e = 0; e < 8; ++e) dst[e] = o[e];
            if (t >= 1) { float* so = C.out + O_SCONV + (size_t)(b * 3 + t - 1) * NCONV + cc; *(f32x4*)so = (f32x4){xp[3 + t][0], xp[3 + t][1], xp[3 + t][2], xp[3 + t][3]}; *(f32x4*)(so + 4) = (f32x4){xp[3 + t][4], xp[3 + t][5], xp[3 + t][6], xp[3 + t][7]}; }
        }
    }
    if (tid < 16) Dts[tid] = softplus_f(C.DTRAW[(m0 + (tid & 3)) * 32 + g * 4 + (tid >> 2)] + C.in[I_DTB][g * 4 + (tid >> 2)]);
    __syncthreads();
    if (tid < 4) { const float A = -__expf(C.in[I_ALOG][g * 4 + tid]); float c = 0.f;
#pragma unroll
        for (int t = 0; t < 4; ++t) { c += Dts[tid * 4 + t] * A; Css[tid * 4 + t] = c; } }
    { const int pair = tid >> 5, l32 = tid & 31, t = pair >> 2, s = pair & 3; float a = 0.f;
#pragma unroll
      for (int k = 0; k < 4; ++k) a += Cs[t * 128 + l32 * 4 + k] * Bs[s * 128 + l32 * 4 + k];
#pragma unroll
      for (int o = 1; o < 32; o <<= 1) a += __shfl_xor(a, o);
      if (l32 == 0) Cbm[pair] = a; }
    __syncthreads();
#pragma unroll
    for (int hl = 0; hl < 4; ++hl) {
        const int h = g * 4 + hl; const size_t so = ((size_t)(b * 32 + h) * 64 + p) * 128 + ns * 4;
        float* sout = C.out + O_SSSM + so;
        float cst[4], dtt[4], xv[4], coef[4], yo[4];
#pragma unroll
        for (int t = 0; t < 4; ++t) { cst[t] = Css[hl * 4 + t]; dtt[t] = Dts[hl * 4 + t]; xv[t] = Xs[(hl * 4 + t) * 64 + p]; }
        const float cdec = __expf(cst[3]);
#pragma unroll
        for (int t = 0; t < 4; ++t) { coef[t] = __expf(cst[3] - cst[t]) * dtt[t] * xv[t]; yo[t] = 0.f; }
#pragma unroll
        for (int k = 0; k < 4; ++k) {
            const f32x4 h0 = hv[hl][k]; f32x4 hn = h0 * cdec;
#pragma unroll
            for (int t = 0; t < 4; ++t) {
                const f32x4 cv = *(const LAS f32x4*)(Cs + t * 128 + ns * 4 + 32 * k), bv = *(const LAS f32x4*)(Bs + t * 128 + ns * 4 + 32 * k);
                yo[t] += (cv.x * h0.x + cv.y * h0.y) + (cv.z * h0.z + cv.w * h0.w);
                hn += bv * coef[t];
            }
            __builtin_nontemporal_store(hn, (f32x4*)(sout + 32 * k));
        }
#pragma unroll
        for (int t = 0; t < 4; ++t) { yo[t] += __shfl_xor(yo[t], 1); yo[t] += __shfl_xor(yo[t], 2); yo[t] += __shfl_xor(yo[t], 4); }
        if (ns == 0) {
            const float Dh = C.in[I_SD][h];
#pragma unroll
            for (int t = 0; t < 4; ++t) {
                float y = __expf(cst[t]) * yo[t] + Dh * xv[t];
#pragma unroll
                for (int s = 0; s < 4; ++s) if (s <= t) y += Cbm[t * 4 + s] * __expf(cst[t] - cst[s]) * dtt[s] * xv[s];
                Yt[t * 256 + hl * 64 + p] = y;
            }
        }
    }
    __syncthreads();
    { const int t = tid >> 7, ch = (tid & 127) * 2; const size_t zo = (m0 + t) * DIN + g * 256 + ch;
      const unsigned zz = *(const unsigned*)(C.Z + zo);
      const float v0 = Yt[t * 256 + ch] * silu_f(bf2f(zz & 0xffffu)), v1 = Yt[t * 256 + ch + 1] * silu_f(bf2f(zz >> 16));
      const float ss = wave_sum(v0 * v0 + v1 * v1);
      if (lane == 0) Red[w] = ss;
      __syncthreads();
      const float rn = 1.0f / sqrtf((Red[2 * t] + Red[2 * t + 1]) * (1.0f / 256.0f) + RMS_EPS);
      *(unsigned*)(C.Z + zo) = pk2(v0 * rn, v1 * rn); }
    __syncthreads();
}
constexpr int SSU0 = 0, SSU1 = 1024;
__device__ __forceinline__ void sample_units(const Ctx& C, int lo, int hi) { for (int u = lo + C.bid; u < hi; u += C.G) ssd_sample_unit(C, u >> 3, u & 7); }
__device__ __forceinline__ void phase_ssd_states(const Ctx& C) {
    for (int u = C.bid; u < 1024; u += C.G) ssd_states_unit(C, u >> 3, u & 7);
    sample_units(C, 0, SSU0);
}
__device__ __forceinline__ void phase_ssd_scan(const Ctx& C) {
    const int gt = C.bid * NTHREADS + C.tid, NGT = C.G * NTHREADS;
    for (int id = gt; id < NBATCH * NSH * 64 * 16; id += NGT) {
        const int n8 = id & 15, p = (id >> 4) & 63, h = (id >> 10) & 31, b = id >> 15;
        float hs[8];
#pragma unroll
        for (int e = 0; e < 8; ++e) hs[e] = 0.f;
#pragma unroll 8
        for (int c = 0; c < NCHUNK; ++c) {
            const size_t off = ((size_t)((b * NCHUNK + c) * NSH + h) * 64 + p) * 128 + n8 * 8;
            const u32x4 sv = *(const u32x4*)(C.ST + off);
            *(u32x4*)(C.HP + off) = pack8(hs);
            float s[8]; unpack8(sv, s); const float dec = C.CDEC[(b * NCHUNK + c) * NSH + h];
#pragma unroll
            for (int e = 0; e < 8; ++e) hs[e] = hs[e] * dec + s[e];
        }
        float* op = C.out + O_PSSM + ((size_t)(b * NSH + h) * 64 + p) * 128 + n8 * 8;
        *(f32x4*)op = (f32x4){hs[0], hs[1], hs[2], hs[3]}; *(f32x4*)(op + 4) = (f32x4){hs[4], hs[5], hs[6], hs[7]};
    }
    __syncthreads();
    sample_units(C, SSU0, SSU1);
}
struct S3Pre { ConvRaw<16> Rc; u32x4 bst[4]; float dr0, dr1; };
__device__ __forceinline__ void s3_prefetch(const Ctx& C, int rb, int g, int r, int tid, S3Pre& P) {
    const size_t row0 = (size_t)rb * 128; const int lane = tid & 63;
#pragma unroll
    for (int i = 0; i < 4; ++i) { const int id = i * NTHREADS + tid, s = id >> 4, c2 = id & 15; P.bst[i] = *(const u32x4*)(C.XC + (row0 + s) * 3072 + 2048 + g * 128 + c2 * 8); }
    conv_load<16>(C, row0, (rb & 31) * 128, 3072 + g * 128, P.Rc);
    const float* dtp = C.DTRAW + (size_t)(rb * 128) * 32 + g * 4 + r; P.dr0 = dtp[(size_t)(2 * lane) * 32]; P.dr1 = dtp[(size_t)(2 * lane + 1) * 32];
}
__device__ __forceinline__ void ssd_out_unit(const Ctx& C, int rb, int g, S3Pre& P, bool has_next, int nrb, int ng) {
    int tid = (int)threadIdx.x; asm volatile("" : "+v"(tid));
    const int w = C.wave, lane = tid & 63, r = w >> 1, psel = w & 1, h = g * 4 + r, ql = lane & 31, hi = lane >> 5;
    LAS bf16_t* Cs = (LAS bf16_t*)C.lds;
    LAS f32x4* CBT = (LAS f32x4*)(C.lds + 34816);
    LAS float* CS = (LAS float*)(C.lds + 75776) + r * 256; LAS float* DTL = CS + 128;
    LAS float* SSQ = (LAS float*)(C.lds + 75776 + 4096);
    LAS bf16_t* Bs = (LAS bf16_t*)(C.lds + 81920);
    LAS bf16_t* Xs = (LAS bf16_t*)(C.lds + 81920);
    const size_t row0 = (size_t)rb * 128;
    const int t0 = (rb & 31) * 128;
    {   u32x4 bvv[4]; const int ch = tid & 15, r0 = (tid >> 4) * 4;
#pragma unroll
        for (int i = 0; i < 4; ++i) { const int id = i * NTHREADS + tid, s = id >> 4, c2 = id & 15; *(LAS u32x4*)(Bs + s * 136 + c2 * 8) = P.bst[i]; }
        conv_compute<16>(C, 3072 + g * 128, P.Rc, bvv, ((rb & 31) == 31) ? C.out + O_PCONV + (size_t)(rb >> 5) * 3 * NCONV : nullptr);
#pragma unroll
        for (int i = 0; i < 4; ++i) *(LAS u32x4*)(Cs + (r0 + i) * 136 + ch * 8) = bvv[i];
    }
    u32x4 xst[8];
#pragma unroll
    for (int i = 0; i < 8; ++i) { const int id = i * NTHREADS + tid, t = id >> 5, ch = id & 31; xst[i] = *(const u32x4*)(C.XC + (row0 + t) * 3072 + g * 256 + ch * 8); }

    const float A = -__expf(C.in[I_ALOG][h]), Dh = C.in[I_SD][h];
    { float cs0, cs1, d0, d1, tot; chunk_scan_v(P.dr0, P.dr1, C.in[I_DTB][h], A, lane, cs0, cs1, d0, d1, tot);
      if (psel == 0) { CS[2 * lane] = cs0; CS[2 * lane + 1] = cs1; DTL[2 * lane] = d0; DTL[2 * lane + 1] = d1; } }
    __syncthreads();
    for (int tile = w; tile < 10; tile += NWAVES) {
        const int lt = (tile >= 6) ? 3 : (tile >= 3) ? 2 : (tile >= 1) ? 1 : 0, st = tile - lt * (lt + 1) / 2;
        f32x16 cb = zero16();
#pragma unroll
        for (int k = 0; k < 8; ++k) { const bf16x8 bfr = *(const LAS bf16x8*)(Bs + (32 * st + ql) * 136 + 16 * k + 8 * hi), cfr = *(const LAS bf16x8*)(Cs + (32 * lt + ql) * 136 + 16 * k + 8 * hi); cb = MFMA32(bfr, cfr, cb); }
#pragma unroll
        for (int q4 = 0; q4 < 4; ++q4) CBT[(tile * 4 + q4) * 64 + lane] = (f32x4){cb[4 * q4], cb[4 * q4 + 1], cb[4 * q4 + 2], cb[4 * q4 + 3]};
    }
    __syncthreads();
#pragma unroll
    for (int i = 0; i < 8; ++i) { const int id = i * NTHREADS + tid, t = id >> 5, ch = id & 31; *(LAS u32x4*)(Xs + t * XP + ch * 8) = xst[i]; }
    bf16x8 hf[2][8];
#pragma unroll
    for (int pt = 0; pt < 2; ++pt) { const bf16_t* hp = C.HP + ((size_t)(rb * 32 + h) * 64 + 32 * pt + ql) * 128 + 8 * hi;
#pragma unroll
        for (int k = 0; k < 8; ++k) hf[pt][k] = *(const bf16x8*)(hp + 16 * k); }
    __syncthreads();
    const int li = lane & 15, gi = (lane >> 4) & 1;
    const LAS bf16_t* xt = Xs + (4 * hi + (li >> 2)) * XP + r * 64 + 16 * gi + 4 * (li & 3);
    for (int lq = 0; lq < 2; ++lq) {
        const int lt = psel ? (1 + lq) : (3 * lq), l = 32 * lt + ql; const size_t lrow = row0 + l;
        u32x4 zq[2][2];
#pragma unroll
        for (int pt = 0; pt < 2; ++pt)
#pragma unroll
            for (int j = 0; j < 2; ++j) zq[pt][j] = *(const u32x4*)(C.Z + lrow * DIN + h * 64 + 32 * pt + 16 * j + 8 * hi);
        if (lq == 1 && has_next) s3_prefetch(C, nrb, ng, r, tid, P);
        const float csl = CS[l];
        f32x16 Y[2]; Y[0] = zero16(); Y[1] = zero16();
        for (int st = 0; st <= lt; ++st) {
            const int tile = lt * (lt + 1) / 2 + st;
            float wv[16];
#pragma unroll
            for (int q4 = 0; q4 < 4; ++q4) {
                const int sb = 32 * st + 8 * q4 + 4 * hi;
                const f32x4 cb4 = CBT[(tile * 4 + q4) * 64 + lane];
                const f32x4 cs4 = *(const LAS f32x4*)(CS + sb), dt4 = *(const LAS f32x4*)(DTL + sb);
#pragma unroll
                for (int e = 0; e < 4; ++e) { const int s = sb + e; float v = cb4[e] * __expf(csl - cs4[e]) * dt4[e]; v = (s <= l) ? v : 0.f; if (s == l) v += Dh; wv[4 * q4 + e] = v; }
            }
            bf16x8 pf[2];
#pragma unroll
            for (int ks = 0; ks < 2; ++ks) { u32x4 pw; pw.x = pk2(wv[8 * ks], wv[8 * ks + 1]); pw.y = pk2(wv[8 * ks + 2], wv[8 * ks + 3]); pw.z = pk2(wv[8 * ks + 4], wv[8 * ks + 5]); pw.w = pk2(wv[8 * ks + 6], wv[8 * ks + 7]); pf[ks] = __builtin_bit_cast(bf16x8, pw); }
#pragma unroll
            for (int pt = 0; pt < 2; ++pt)
#pragma unroll
                for (int ks = 0; ks < 2; ++ks) {
                    const LAS bf16_t* xp = xt + (32 * st + 16 * ks) * XP + pt * 32;
                    const bf16x8 xf = cat8(lds_tr4(xp), lds_tr4(xp + 8 * XP));
                    Y[pt] = MFMA32(xf, pf[ks], Y[pt]);
                }
        }
        const float el = __expf(csl);
        bf16x8 cf[8];
#pragma unroll
        for (int k = 0; k < 8; ++k) cf[k] = *(const LAS bf16x8*)(Cs + l * 136 + 16 * k + 8 * hi);
#pragma unroll
        for (int pt = 0; pt < 2; ++pt) {
            f32x16 y2 = zero16();
#pragma unroll
            for (int k = 0; k < 8; ++k) y2 = MFMA32(hf[pt][k], cf[k], y2);
#pragma unroll
            for (int rg = 0; rg < 16; ++rg) Y[pt][rg] += el * y2[rg];
        }
        float ss = 0.f;
#pragma unroll
        for (int pt = 0; pt < 2; ++pt)
#pragma unroll
            for (int q4 = 0; q4 < 4; ++q4) {
                u32x2 z2;
                { const u32x4 zv = zq[pt][q4 >> 1];
                  auto s0 = __builtin_amdgcn_permlane32_swap(zv.x, zv.z, false, false); auto s1 = __builtin_amdgcn_permlane32_swap(zv.y, zv.w, false, false);
                  z2.x = (q4 & 1) ? s0[1] : s0[0]; z2.y = (q4 & 1) ? s1[1] : s1[0]; }
                const float z0 = bf2f(z2.x & 0xffffu), z1 = bf2f(z2.x >> 16), z2f = bf2f(z2.y & 0xffffu), z3 = bf2f(z2.y >> 16);
                float v;
                v = Y[pt][4 * q4 + 0] * silu_f(z0); Y[pt][4 * q4 + 0] = v; ss += v * v;
                v = Y[pt][4 * q4 + 1] * silu_f(z1); Y[pt][4 * q4 + 1] = v; ss += v * v;
                v = Y[pt][4 * q4 + 2] * silu_f(z2f); Y[pt][4 * q4 + 2] = v; ss += v * v;
                v = Y[pt][4 * q4 + 3] * silu_f(z3); Y[pt][4 * q4 + 3] = v; ss += v * v;
            }
        ss += __shfl_xor(ss, 32);
        if (hi == 0) SSQ[r * 128 + l] = ss;
        __syncthreads();
        const float tot = (SSQ[l] + SSQ[128 + l]) + (SSQ[256 + l] + SSQ[384 + l]);
        const float rn = 1.0f / sqrtf(tot * (1.0f / 256.0f) + RMS_EPS);
#pragma unroll
        for (int pt = 0; pt < 2; ++pt)
#pragma unroll
            for (int j = 0; j < 2; ++j) {
                const int qa = 2 * j, qb = 2 * j + 1;
                const unsigned x0 = pk2(Y[pt][4 * qa] * rn, Y[pt][4 * qa + 1] * rn), x1 = pk2(Y[pt][4 * qa + 2] * rn, Y[pt][4 * qa + 3] * rn);
                const unsigned y0 = pk2(Y[pt][4 * qb] * rn, Y[pt][4 * qb + 1] * rn), y1 = pk2(Y[pt][4 * qb + 2] * rn, Y[pt][4 * qb + 3] * rn);
                auto s0 = __builtin_amdgcn_permlane32_swap(x0, y0, false, false); auto s1 = __builtin_amdgcn_permlane32_swap(x1, y1, false, false);
                u32x4 ov; ov.x = s0[0]; ov.y = s1[0]; ov.z = s0[1]; ov.w = s1[1];
                *(u32x4*)(C.Z + lrow * DIN + h * 64 + 32 * pt + 16 * j + 8 * hi) = ov;
            }
    }
    __syncthreads();
}
__device__ __forceinline__ void phase_ssd_out(const Ctx& C) {
    { int u = C.bid; if (u < 1024) { S3Pre P; int t0_ = (int)threadIdx.x; asm volatile("" : "+v"(t0_)); s3_prefetch(C, u >> 3, u & 7, C.wave >> 1, t0_, P);
          for (; u < 1024; u += C.G) { const int nu = u + C.G; ssd_out_unit(C, u >> 3, u & 7, P, nu < 1024, nu >> 3, nu & 7); } } }
    sample_units(C, SSU1, 1024);
}
template <int K> __device__ __forceinline__ void skinny_resid(const Ctx& C, const bf16_t* A, const bf16_t* Bt) {
    constexpr int KC = 256, NCK = K / KC, SP = KC + 8, BUF = 96 * SP;
    static_assert(K % KC == 0, "K chunks");
    LAS bf16_t* buf = (LAS bf16_t*)C.lds;
    LAS float* red = (LAS float*)(C.lds + 2 * BUF * 2);
    int tid = (int)threadIdx.x; asm volatile("" : "+v"(tid));
    const int w = C.wave, lane = tid & 63, r16 = lane & 15, kq = lane >> 4, rt = w >> 2, ct = w & 3;
    for (int pc = C.bid; pc < 256; pc += C.G) {
        const int rg = pc >> 4, cgp = pc & 15;
        const bf16_t* src[6]; int dsto[6];
#pragma unroll
        for (int i = 0; i < 6; ++i) { const int id = i * NTHREADS + tid, row = id >> 5, ch = id & 31;
            src[i] = (row < 32 ? A + (size_t)(MP + 32 * rg + row) * K : Bt + (size_t)(64 * cgp + row - 32) * K) + ch * 8; dsto[i] = row * SP + ch * 8; }
        u32x4 st[2][6];
#pragma unroll
        for (int i = 0; i < 6; ++i) st[0][i] = *(const u32x4*)src[i];
        if (NCK > 1) {
#pragma unroll
            for (int i = 0; i < 6; ++i) st[1][i] = *(const u32x4*)(src[i] + KC); }
#pragma unroll
        for (int i = 0; i < 6; ++i) *(LAS u32x4*)(buf + dsto[i]) = st[0][i];
        __syncthreads();
        f32x4 acc = (f32x4){0.f, 0.f, 0.f, 0.f};
#pragma unroll
        for (int kc = 0; kc < NCK; ++kc) {
            if (kc + 2 < NCK) {
#pragma unroll
                for (int i = 0; i < 6; ++i) st[kc & 1][i] = *(const u32x4*)(src[i] + (size_t)(kc + 2) * KC); }
            const LAS bf16_t* ab = buf + (kc & 1) * BUF + (rt * 16 + r16) * SP + 8 * kq; const LAS bf16_t* bb = buf + (kc & 1) * BUF + (32 + ct * 16 + r16) * SP + 8 * kq;
#pragma unroll
            for (int ks = 0; ks < 8; ++ks) { const bf16x8 af = *(const LAS bf16x8*)(ab + 32 * ks), bfr = *(const LAS bf16x8*)(bb + 32 * ks); acc = __builtin_amdgcn_mfma_f32_16x16x32_bf16(bfr, af, acc, 0, 0, 0); }
            if (kc + 1 < NCK) {
#pragma unroll
                for (int i = 0; i < 6; ++i) *(LAS u32x4*)(buf + ((kc + 1) & 1) * BUF + dsto[i]) = st[(kc + 1) & 1][i]; }
            __syncthreads();
        }
        {
            const int srow = 32 * rg + rt * 16 + r16, col = 64 * cgp + 16 * ct + 4 * kq; const size_t grow = (size_t)MP + srow;
            const u32x2 ow = *(const u32x2*)(C.XB + grow * DM + col);
            f32x4 v = acc + (f32x4){bf2f(ow.x & 0xffffu), bf2f(ow.x >> 16), bf2f(ow.y & 0xffffu), bf2f(ow.y >> 16)};
            float ss = (v.x * v.x + v.y * v.y) + (v.z * v.z + v.w * v.w);
            ss += __shfl_xor(ss, 16); ss += __shfl_xor(ss, 32);
            u32x2 wv; wv.x = pk2(v.x, v.y); wv.y = pk2(v.z, v.w); *(u32x2*)(C.XB + grow * DM + col) = wv;
            if (kq == 0) red[(rt * 4 + ct) * 16 + r16] = ss;
        }
        __syncthreads();
        if (tid < 32) { const int rr = tid; const LAS float* rp = red + (rr >> 4) * 64 + (rr & 15);
            C.PART[((size_t)MP + 32 * rg + rr) * 16 + cgp] = (rp[0] + rp[16]) + (rp[32] + rp[48]); }
        __syncthreads();
    }
}
#define RLX_AGENT __ATOMIC_RELAXED, __HIP_MEMORY_SCOPE_AGENT
#define XB_TMO      128
#define XB_XCNT(j)  (256  + 64 * (j))
#define XB_XSUB(j)  (1280 + 64 * (j))
#define XB_XGEN(j)  (2304 + 64 * (j))
#define XB_TOP      3328
#define XB_TOPGEN   3392
#define XCD_BAR_WORDS 3456
#define XB_SPIN_CAP (1u << 18)

__device__ __forceinline__ unsigned xb_ld(unsigned* p)              { return __hip_atomic_load(p, __ATOMIC_RELAXED, __HIP_MEMORY_SCOPE_AGENT); }
__device__ __forceinline__ unsigned xb_add(unsigned* p, unsigned v) { return __hip_atomic_fetch_add(p, v, __ATOMIC_RELAXED, __HIP_MEMORY_SCOPE_AGENT); }
__device__ __forceinline__ unsigned xb_xcc_id() { return (unsigned)__builtin_amdgcn_s_getreg((3 << 11) | 20) & 0xFu; }
#define XB_SPIN(cond, bar) do { unsigned _sp = 0; while (cond) { __builtin_amdgcn_s_sleep(1); \
    if ((++_sp & 255u) == 0u) { if (xb_ld(&(bar)[XB_TMO])) break; if (_sp > XB_SPIN_CAP) { atomicAdd(&(bar)[XB_TMO], 1u); break; } } } } while (0)

struct XcdBarrier {
    unsigned* bar; unsigned x;
    volatile LAS unsigned* st;
};

__device__ __forceinline__ XcdBarrier xcd_barrier_post(unsigned* bar, volatile LAS unsigned* st) {
    XcdBarrier b; b.bar = bar; b.x = xb_xcc_id(); b.st = st;
    if (threadIdx.x == 0) (void)xb_add(&bar[XB_XCNT(b.x)], 1u);
    return b;
}
__device__ __forceinline__ void xcd_barrier_complete(unsigned* bar, unsigned x, unsigned& nloc, unsigned& nx) {
    const unsigned G = gridDim.x * gridDim.y * gridDim.z;
    unsigned sum, cnt, mine, sp = 0u;
    for (;;) {
        sum = 0u; cnt = 0u; mine = 0u;
#pragma unroll
        for (unsigned j = 0; j < 16; ++j) { const unsigned c = xb_ld(&bar[XB_XCNT(j)]); sum += c; cnt += (c > 0u) ? 1u : 0u; mine = (j == x) ? c : mine; }
        if (sum == G) break;
        __builtin_amdgcn_s_sleep(1);
        if ((++sp & 255u) == 0u) { if (xb_ld(&bar[XB_TMO])) break; if (sp > XB_SPIN_CAP) { atomicAdd(&bar[XB_TMO], 1u); break; } }
    }
    nloc = mine > 0u ? mine : 1u; nx = cnt > 0u ? cnt : 1u;
}

__device__ __forceinline__ void xcd_barrier(const XcdBarrier& b) {
    asm volatile("s_waitcnt vmcnt(0)" ::: "memory");
    __syncthreads();
    if (threadIdx.x == 0) {
        unsigned* bar = b.bar;
        __builtin_amdgcn_s_waitcnt(0);
        unsigned nloc = b.st[0], nx = b.st[1];
        if (nloc == 0u) { xcd_barrier_complete(bar, b.x, nloc, nx); b.st[0] = nloc; b.st[1] = nx; }
        const unsigned old = xb_add(&bar[XB_XSUB(b.x)], 1u);
        const unsigned gen = old / nloc;
        if (old + 1u == (gen + 1u) * nloc) {
            __builtin_amdgcn_fence(__ATOMIC_RELEASE, "agent");
            asm volatile("s_waitcnt vmcnt(0)" ::: "memory");
            const unsigned og = xb_add(&bar[XB_TOP], 1u);
            const unsigned tg = og / nx;
            if (og + 1u == (tg + 1u) * nx) xb_add(&bar[XB_TOPGEN], 1u);
            else XB_SPIN(xb_ld(&bar[XB_TOPGEN]) == tg, bar);
            __builtin_amdgcn_fence(__ATOMIC_ACQUIRE, "agent");
            xb_add(&bar[XB_XGEN(b.x)], 1u);
            asm volatile("s_waitcnt vmcnt(0)" ::: "memory");
        } else {
            XB_SPIN(xb_ld(&bar[XB_XGEN(b.x)]) == gen, bar);
            __builtin_amdgcn_fence(__ATOMIC_ACQUIRE, "agent");
            asm volatile("s_waitcnt vmcnt(0)" ::: "memory");
        }
    }
    __syncthreads();
}

#ifndef MK_ONE_LAUNCH
#define MK_ONE_LAUNCH 1
#endif
constexpr int N_PHASES = 17;
template <class Epi> __device__ __forceinline__ void run_gemm(const Ctx& C, const bf16_t* A, const bf16_t* Bt, int N, int K, const Epi& E, int M = MT) {
    pg8::Gemm g{A, Bt, M, N, K}; pg8::StaticOrder S; S.init(M, N, C.G, C.bid);
    if constexpr (Epi::NEEDS_RSTD) pg8::phase_rstd_table(E.part, S, E.RS);
    pg8::gemm_phase<Epi, pg8::StaticOrder, true, true>(C.lds, g, S, E);
}
__global__ void __launch_bounds__(NTHREADS, 2) hybrid_fwd(Args a) {
    extern __shared__ __attribute__((aligned(16))) unsigned char lds_raw[];
    Ctx C;
#pragma unroll
    for (int i = 0; i < 26; ++i) C.in[i] = a.in[i];
    C.out = a.out; C.ws = a.ws; C.lds = (LAS unsigned char*)lds_raw;
    C.tid = threadIdx.x; C.lane = C.tid & 63; C.wave = __builtin_amdgcn_readfirstlane(C.tid >> 6); C.G = gridDim.x; C.bid = blockIdx.x;
    unsigned char* ws = a.ws;
    C.PART = (float*)(ws + WS_PART); C.BIASD = (float*)(ws + WS_BIASD); C.CDEC = (float*)(ws + WS_CDEC); C.DTRAW = (float*)(ws + WS_DTRAW); C.U0 = (float*)(ws + WS_U0); C.UL = (float*)(ws + WS_UL);
    C.WQKV = (bf16_t*)(ws + WS_WQKV); C.WO = (bf16_t*)(ws + WS_WO); C.WIN = (bf16_t*)(ws + WS_WIN); C.WOUT = (bf16_t*)(ws + WS_WOUT); C.WUP = (bf16_t*)(ws + WS_WUP); C.WDN = (bf16_t*)(ws + WS_WDN);
    C.XB = (bf16_t*)(ws + WS_XB); C.QKV = (bf16_t*)(ws + WS_QKV); C.AO = (bf16_t*)(ws + WS_AO); C.ACT = (bf16_t*)(ws + WS_ACT); C.Z = (bf16_t*)(ws + WS_Z); C.XBC = (bf16_t*)(ws + WS_XBC);
    C.ST = (bf16_t*)(ws + WS_ST); C.HP = (bf16_t*)(ws + WS_HP); C.XC = (bf16_t*)(ws + WS_XC);
    const int lo = a.ph_lo, hi = a.ph_hi;
    volatile LAS unsigned* MISC = (volatile LAS unsigned*)(C.lds + LDSCTL_OFF);
    if (C.tid < 16) MISC[C.tid] = 0u;
    __syncthreads();
    XcdBarrier bar; bar.bar = (unsigned*)(ws + WS_CTL); bar.x = 0; bar.st = nullptr;
    if (a.coop) bar = xcd_barrier_post((unsigned*)(ws + WS_CTL), MISC + 8);
#define IN(k) (lo <= (k) && (k) < hi)
#define FRESH() do { int t_ = threadIdx.x; asm volatile("" : "+v"(t_)); C.tid = t_; C.lane = t_ & 63; C.wave = __builtin_amdgcn_readfirstlane(t_ >> 6); } while (0)
#ifndef CG_SEAM_MASK
#define CG_SEAM_MASK 0x0u
#endif
#define SEAM(k) do { if (IN(k) && IN((k) + 1)) { if ((CG_SEAM_MASK >> (k)) & 1u) cg::this_grid().sync(); else xcd_barrier(bar); } } while (0)
    if (IN(0)) { FRESH(); phase_prologue(C);  __syncthreads(); } SEAM(0);
    if (IN(1)) { FRESH(); pg8::EpiScale<0> E{C.PART, C.QKV, NQKV, nullptr, nullptr, (LAS float*)(C.lds + RING_BYTES + 16384)}; run_gemm(C, C.XB, C.WQKV, NQKV, DM, E); convert_in_tail<1>(C, (MT / 256) * (NQKV / 256));  __syncthreads(); } SEAM(1);
    if (IN(2)) { FRESH(); phase_attention(C);  __syncthreads(); } SEAM(2);
    if (IN(3)) { FRESH(); pg8::EpiResid E{C.XB, C.PART}; run_gemm(C, C.AO, C.WO, DM, DM, E, MP); skinny_resid<DM>(C, C.AO, C.WO);  __syncthreads(); } SEAM(3);
    if (IN(4)) { FRESH(); pg8::EpiConvAct E{C.PART, C.ACT, C.in[I_FCW], C.in[I_FCB], C.in[I_SFFN], C.U0, C.UL, C.out + O_PFFN, C.out + O_SFFN, (LAS float*)(C.lds + RING_BYTES), (LAS float*)(C.lds + RING_BYTES + 16384), (LAS float*)(C.lds + RING_BYTES + 8192)}; run_gemm(C, C.XB, C.WUP, NUP, DM, E); convert_in_tail<2>(C, (MT / 256) * (NUP / 256));  __syncthreads(); } SEAM(4);
    if (IN(6)) { FRESH(); { pg8::StaticOrder S_; pg8::Unit u_; S_.init(MP, DM, C.G, C.bid); for (int i_ = 0; S_.next(i_, u_); ++i_) ffn_fixup_tile(C, 0, u_.pm); } pg8::EpiResid E{C.XB, C.PART}; run_gemm(C, C.ACT, C.WDN, DM, DFF, E, MP); skinny_resid<DFF>(C, C.ACT, C.WDN);  __syncthreads(); } SEAM(6);
    if (IN(7)) { FRESH(); pg8::EpiScale<2> E{C.PART, C.Z, DIN, C.XBC, C.DTRAW, (LAS float*)(C.lds + RING_BYTES + 16384)}; run_gemm(C, C.XB, C.WIN, NINP, DM, E); convert_in_tail<3>(C, (MT / 256) * (NINP / 256));  __syncthreads(); } SEAM(7);
    if (IN(9)) { FRESH(); phase_ssd_states(C);  __syncthreads(); } SEAM(9);
    if (IN(10)) { FRESH(); phase_ssd_scan(C);  __syncthreads(); } SEAM(10);
    if (IN(11)) { FRESH(); phase_ssd_out(C);  __syncthreads(); } SEAM(11);
    if (IN(12)) { FRESH(); pg8::EpiResid E{C.XB, C.PART}; run_gemm(C, C.Z, C.WOUT, DM, DIN, E, MP); skinny_resid<DIN>(C, C.Z, C.WOUT);  __syncthreads(); } SEAM(12);
    if (IN(13)) { FRESH(); pg8::EpiConvAct E{C.PART, C.ACT, C.in[I_FCW] + 3 * NUP, C.in[I_FCB] + NUP, C.in[I_SFFN] + (size_t)SBATCH * 2 * NUP, C.U0, C.UL, C.out + O_PFFN + 4 * 2 * NUP, C.out + O_SFFN + (size_t)SBATCH * 2 * NUP, (LAS float*)(C.lds + RING_BYTES), (LAS float*)(C.lds + RING_BYTES + 16384), (LAS float*)(C.lds + RING_BYTES + 8192)}; run_gemm(C, C.XB, C.WUP + (size_t)NUP * DM, NUP, DM, E); convert_in_tail<4>(C, (MT / 256) * (NUP / 256));  __syncthreads(); } SEAM(13);
    if (IN(15)) { FRESH(); { pg8::StaticOrder S_; pg8::Unit u_; S_.init(MP, DM, C.G, C.bid); for (int i_ = 0; S_.next(i_, u_); ++i_) ffn_fixup_tile(C, 1, u_.pm); } pg8::EpiResid E{C.XB, C.PART}; run_gemm(C, C.ACT, C.WDN + (size_t)DM * DFF, DM, DFF, E, MP); skinny_resid<DFF>(C, C.ACT, C.WDN + (size_t)DM * DFF);  __syncthreads(); } SEAM(15);
    if (IN(16)) { FRESH(); phase_final_norm(C); __syncthreads(); }
#undef IN
#undef SEAM
}

extern "C" void kernel_launch(void* const* d_in, const int* in_sizes, int n_in, void* d_out, int out_size, void* d_ws, size_t ws_size, hipStream_t stream) {
    static int grid = 0;
    if (grid == 0) {
        if (n_in != 26 || (size_t)out_size != O_END || ws_size < WS_END) { fprintf(stderr, "kernel_launch: unexpected problem: n_in %d out %d ws %zu (need %zu)\n", n_in, out_size, ws_size, (size_t)WS_END); grid = -1; return; }
        int dev = 0, cus = 0, per_cu = 0;
        if (hipGetDevice(&dev) != hipSuccess || hipDeviceGetAttribute(&cus, hipDeviceAttributeMultiprocessorCount, dev) != hipSuccess) { grid = -1; return; }
        if (hipFuncSetAttribute((const void*)hybrid_fwd, hipFuncAttributeMaxDynamicSharedMemorySize, LDS_BYTES) != hipSuccess) { fprintf(stderr, "kernel_launch: hipFuncSetAttribute failed\n"); grid = -1; return; }
        if (hipOccupancyMaxActiveBlocksPerMultiprocessor(&per_cu, (const void*)hybrid_fwd, NTHREADS, LDS_BYTES) != hipSuccess || per_cu < 1) { fprintf(stderr, "kernel_launch: occupancy query says %d\n", per_cu); per_cu = 1; (void)hipGetLastError(); }
        grid = cus * (per_cu > 1 ? 1 : per_cu);
    }
    if (grid < 0) return;
    Args a{};
    for (int i = 0; i < 26; ++i) a.in[i] = (const float*)d_in[i];
    a.out = (float*)d_out; a.ws = (unsigned char*)d_ws;
#if MK_ONE_LAUNCH
    if (hipMemsetAsync((char*)d_ws + WS_CTL, 0, 16384, stream) != hipSuccess) { fprintf(stderr, "kernel_launch: memset failed\n"); return; }
    a.ph_lo = 0; a.ph_hi = N_PHASES; a.coop = 1;
    void* args[] = {&a};
    hipError_t e = hipLaunchCooperativeKernel((const void*)hybrid_fwd, dim3(grid), dim3(NTHREADS), args, LDS_BYTES, stream);
    if (e != hipSuccess) fprintf(stderr, "kernel_launch: cooperative launch failed: %s (grid %d)\n", hipGetErrorString(e), grid);
#else
    for (int p = 0; p < N_PHASES; ++p) {
        a.ph_lo = p; a.ph_hi = p + 1; a.coop = 0;
        hipLaunchKernelGGL(hybrid_fwd, dim3(grid), dim3(NTHREADS), LDS_BYTES, stream, a);
    }
#endif
}
```

```cpp
#include <hip/hip_runtime.h>
#include <hip/hip_cooperative_groups.h>
#include <cstdio>
#include <cstdint>
namespace cg = cooperative_groups;

#define LAS __attribute__((address_space(3)))
typedef unsigned short bf16_t;
typedef short bf16x8 __attribute__((ext_vector_type(8)));
typedef short s16x4 __attribute__((ext_vector_type(4)));
typedef float f32x4 __attribute__((ext_vector_type(4)));
typedef float f32x2 __attribute__((ext_vector_type(2)));
typedef float f32x16 __attribute__((ext_vector_type(16)));
typedef unsigned u32x4 __attribute__((ext_vector_type(4)));
typedef unsigned u32x2 __attribute__((ext_vector_type(2)));
typedef __bf16 bf16x2_t __attribute__((ext_vector_type(2)));

constexpr int DM = 1024, NBATCH = 4, SEQ = 4096, MP = NBATCH * SEQ, SBATCH = 128, SLEN = 4, MS = SBATCH * SLEN, MT = MP + MS;
constexpr int NQKV = 1536, DFF = 2816, NUP = 2 * DFF, DIN = 2048, NCONV = 4096, NIN = 6176, NINP = 6400, NSH = 32, NSG = 8, DSTATE = 128;
constexpr int NCHUNK = SEQ / 128;
constexpr float RMS_EPS = 1e-6f;
constexpr float LOG2E = 1.4426950408889634f;

constexpr size_t MiB = 1u << 20;
constexpr size_t WS_CTL = 0;
constexpr size_t WS_PART = 1 * MiB;
constexpr size_t WS_BIASD = 3 * MiB;
constexpr size_t WS_CDEC = 3 * MiB + 65536;
constexpr size_t WS_DTRAW = 4 * MiB;
constexpr size_t WS_WQKV = 12 * MiB, WS_WO = 15 * MiB, WS_WIN = 17 * MiB, WS_WOUT = 30 * MiB, WS_WUP = 34 * MiB  , WS_WDN = 56 * MiB  ;
constexpr size_t WS_XB = 67 * MiB;
constexpr size_t WS_OV = 133 * MiB;
constexpr size_t WS_QKV = WS_OV, WS_AO = WS_OV + 50 * MiB;
constexpr size_t WS_U0 = WS_OV, WS_UL = WS_OV + 3 * MiB, WS_ACT = WS_OV + 182 * MiB;
constexpr size_t WS_Z = WS_OV, WS_XBC = WS_OV + 66 * MiB;
constexpr size_t WS_ST = WS_OV + 198 * MiB, WS_HP = WS_ST;
constexpr size_t WS_XC = WS_OV + 262 * MiB;
constexpr size_t WS_END = WS_OV + 361 * MiB;
static_assert(WS_WQKV + (size_t)NQKV * DM * 2 <= WS_WO && WS_WO + (size_t)DM * DM * 2 <= WS_WIN && WS_WIN + (size_t)NINP * DM * 2 <= WS_WOUT && WS_WOUT + (size_t)DM * DIN * 2 <= WS_WUP &&
              WS_WUP + 2 * (size_t)NUP * DM * 2 <= WS_WDN && WS_WDN + 2 * (size_t)DM * DFF * 2 <= WS_XB && WS_XB + (size_t)MT * DM * 2 <= WS_OV, "weights map");
static_assert(WS_QKV + (size_t)MT * NQKV * 2 <= WS_AO && WS_AO + (size_t)MT * DM * 2 <= WS_END && WS_UL + (size_t)66 * 2 * NUP * 4 <= WS_ACT && WS_U0 + (size_t)66 * 2 * NUP * 4 <= WS_UL && WS_ACT + (size_t)MT * DFF * 2 <= WS_END &&
              WS_Z + (size_t)MT * DIN * 2 <= WS_XBC && WS_XBC + (size_t)MT * NCONV * 2 <= WS_ST && WS_ST + (size_t)MP * DIN * 2 <= WS_XC && WS_XC + (size_t)MP * 3072 * 2 <= WS_END &&
              WS_PART + (size_t)MT * 64 <= WS_BIASD && WS_DTRAW + (size_t)MT * 128 <= WS_WQKV, "overlay map");

constexpr size_t O_YP = 0, O_YS = O_YP + (size_t)MP * DM, O_PK = O_YS + (size_t)MS * DM, O_PV = O_PK + 4 * 128 * 256, O_PCONV = O_PV + 4 * 128 * 256, O_PSSM = O_PCONV + 4 * 3 * NCONV,
                 O_PFFN = O_PSSM + (size_t)4 * 32 * 64 * 128, O_SK = O_PFFN + 2 * 4 * 2 * NUP, O_SV = O_SK + (size_t)128 * 128 * 256, O_SCONV = O_SV + (size_t)128 * 128 * 256,
                 O_SSSM = O_SCONV + (size_t)128 * 3 * NCONV, O_SFFN = O_SSSM + (size_t)128 * 32 * 64 * 128, O_END = O_SFFN + (size_t)2 * 128 * 2 * NUP;

__device__ __forceinline__ float bf2f(unsigned v) { return __uint_as_float(v << 16); }
__device__ __forceinline__ unsigned pk2(float lo, float hi) { f32x2 v = {lo, hi}; bf16x2_t b = __builtin_convertvector(v, bf16x2_t); return __builtin_bit_cast(unsigned, b); }
__device__ __forceinline__ float wave_sum(float v) {
#pragma unroll
    for (int o = 1; o < 64; o <<= 1) v += __shfl_xor(v, o);
    return v;
}
__device__ __forceinline__ float wave_max(float v) {
#pragma unroll
    for (int o = 1; o < 64; o <<= 1) v = fmaxf(v, __shfl_xor(v, o));
    return v;
}
__device__ __forceinline__ float silu_f(float v) { return v * __builtin_amdgcn_rcpf(1.0f + __builtin_amdgcn_exp2f(-LOG2E * v)); }
__device__ __forceinline__ int crow(int r, int hi) { return (r & 3) + 8 * (r >> 2) + 4 * hi; }
__device__ __forceinline__ void unpack8(const u32x4 v, float (&f)[8]) {
    f[0] = bf2f(v.x & 0xffffu); f[1] = bf2f(v.x >> 16); f[2] = bf2f(v.y & 0xffffu); f[3] = bf2f(v.y >> 16);
    f[4] = bf2f(v.z & 0xffffu); f[5] = bf2f(v.z >> 16); f[6] = bf2f(v.w & 0xffffu); f[7] = bf2f(v.w >> 16);
}
__device__ __forceinline__ u32x4 pack8(const float (&f)[8]) { u32x4 o; o.x = pk2(f[0], f[1]); o.y = pk2(f[2], f[3]); o.z = pk2(f[4], f[5]); o.w = pk2(f[6], f[7]); return o; }
__device__ __forceinline__ float row_rstd(const float* part, int row) {
    const f32x4* p = (const f32x4*)(part + (size_t)row * 16);
    const f32x4 a = p[0], b = p[1], c = p[2], d = p[3];
    const float s = ((a.x + a.y) + (a.z + a.w)) + ((b.x + b.y) + (b.z + b.w)) + ((c.x + c.y) + (c.z + c.w)) + ((d.x + d.y) + (d.z + d.w));
    return 1.0f / sqrtf(s * (1.0f / DM) + RMS_EPS);
}
namespace pg8 {
#define PG8_LAS __attribute__((address_space(3)))
typedef unsigned short bf16_t;
typedef short bf16x8 __attribute__((ext_vector_type(8)));
typedef float f32x4 __attribute__((ext_vector_type(4)));
typedef unsigned u32x4 __attribute__((ext_vector_type(4)));
constexpr int BM = 256, BK = 64, HALF = 128, HTB = HALF * BK * 2  , STAGE_BYTES = 8 * HTB, NXCD = 8, WGM = 8;

__host__ __device__ __forceinline__ int lds_byte(int r, int c) { const int st = (r >> 4) * 2 + (c >> 5), rr = r & 15, cc = c & 31, ob = rr * 64 + cc * 2; return st * 1024 + (ob ^ (((ob >> 9) & 1) << 5)); }
__host__ __device__ __forceinline__ void stage_rc(int b, int& R, int& C) { const int st = b / 1024, sb = b % 1024, swz = sb ^ (((sb >> 9) & 1) << 5); R = (st >> 1) * 16 + swz / 64; C = (st & 1) * 32 + (swz % 64) / 2; }
__host__ __device__ __forceinline__ int perm32(int rho) { const int n = rho >> 4, i = rho & 15; return 8 * (i >> 2) + 4 * n + (i & 3); }

struct Unit { int pm, pn, idx; };
struct Gemm { const bf16_t* A; const bf16_t* Bt; int M, N, K; };

struct StaticOrder {
    int nM, nN, nwg, G, c;
    __host__ __device__ __forceinline__ void init(int M, int N, int G_, int c_) { nM = M / BM; nN = N / BM; nwg = nM * nN; G = G_; c = c_; }
    __host__ __device__ __forceinline__ bool next(int i, Unit& u) const {
        const long L = (long)i * G + c; if (L >= nwg) return false;
        int wgid = (int)L; { const int q = nwg / NXCD, r = nwg % NXCD, xcd = wgid % NXCD, off = wgid / NXCD; wgid = (xcd < r ? xcd * (q + 1) : r * (q + 1) + (xcd - r) * q) + off; }
        const int nig = WGM * nN, gid = wgid / nig, fm = gid * WGM, gsz = (nM - fm) < WGM ? (nM - fm) : WGM;
        u.pm = fm + ((wgid % nig) % gsz); u.pn = (wgid % nig) / gsz; u.idx = i; return true;
    }
    __device__ __forceinline__ void a_ready(const Unit&) const {}
    __device__ __forceinline__ void done(const Unit&) const {}
};


template <class Sched> __device__ __forceinline__ void phase_rstd_table(const float* part, const Sched& S, PG8_LAS float* RS) {
    Unit u; const int t = threadIdx.x;
    for (int i = 0; S.next(i, u); ++i) if (t < 256) RS[i * 256 + t] = row_rstd(part, u.pm * BM + t);
    __syncthreads();
}
#define PG8_EPI_BARRIER() do { asm volatile("s_waitcnt lgkmcnt(0)" ::: "memory"); __builtin_amdgcn_s_barrier(); asm volatile("" ::: "memory"); } while (0)
template <int MODE> struct EpiScale {
    static constexpr bool PERM = true, AFTER_DRAIN = false, NEEDS_RSTD = true, WANTS_NEXT = false;
    const float* part; bf16_t* O0; int ldc; bf16_t* O1; float* F; PG8_LAS float* RS;
    __device__ __forceinline__ void operator()(const f32x4 (&acc)[2][2][4][2], const Unit& u, int wr, int wc, int fr, int fq) const {
        const int colt = u.pn * BM; bf16_t* base = O0; int ld = ldc, cl = colt; bool dtile = false;
        if (MODE == 2) { if (colt < 2048) { base = O0; ld = 2048; cl = colt; } else if (colt < 6144) { base = O1; ld = 4096; cl = colt - 2048; } else { dtile = true; } }
        const int row0 = u.pm * BM + wr * 64 + fr, col0 = cl + wc * 32 + 8 * fq;
#pragma unroll
        for (int ai = 0; ai < 2; ++ai)
#pragma unroll
            for (int m = 0; m < 4; ++m) {
                const int row = row0 + ai * HALF + m * 16; const float rs = RS[u.idx * 256 + ai * HALF + wr * 64 + m * 16 + fr];
                if (MODE == 2 && dtile) {
                    if (wc == 0) { float* fp = F + (size_t)row * 32 + 8 * fq; *(f32x4*)fp = acc[ai][0][m][0] * rs; *(f32x4*)(fp + 4) = acc[ai][0][m][1] * rs; }
                } else {
                    bf16_t* rowp = base + (size_t)row * ld + col0;
#pragma unroll
                    for (int bj = 0; bj < 2; ++bj) { const f32x4 v0 = acc[ai][bj][m][0] * rs, v1 = acc[ai][bj][m][1] * rs;
                        u32x4 w; w.x = pk2(v0[0], v0[1]); w.y = pk2(v0[2], v0[3]); w.z = pk2(v1[0], v1[1]); w.w = pk2(v1[2], v1[3]);
                        *(u32x4*)(rowp + bj * HALF) = w; }
                }
            }
    }
};
__device__ __forceinline__ float dpp_ror1(float v) { return __builtin_bit_cast(float, __builtin_amdgcn_update_dpp(0, __builtin_bit_cast(int, v), 0x121, 0xf, 0xf, false)); }
__device__ __forceinline__ float dpp_ror2(float v) { return __builtin_bit_cast(float, __builtin_amdgcn_update_dpp(0, __builtin_bit_cast(int, v), 0x122, 0xf, 0xf, false)); }
__device__ __forceinline__ float dpp_shr1(float old, float v) { return __builtin_bit_cast(float, __builtin_amdgcn_update_dpp(__builtin_bit_cast(int, old), __builtin_bit_cast(int, v), 0x111, 0xf, 0xf, false)); }
__device__ __forceinline__ float dpp_shr2(float old, float v) { return __builtin_bit_cast(float, __builtin_amdgcn_update_dpp(__builtin_bit_cast(int, old), __builtin_bit_cast(int, v), 0x112, 0xf, 0xf, false)); }
struct EpiConvAct {
    static constexpr bool PERM = true, AFTER_DRAIN = false, NEEDS_RSTD = true, WANTS_NEXT = true;
    const float* part; bf16_t* ACT; const float* cw; const float* cb; const float* st; float* U0; float* UL; float* outp; float* outs; PG8_LAS float* X; PG8_LAS float* RS; PG8_LAS float* W;
    __device__ __forceinline__ void operator()(const f32x4 (&acc)[2][2][4][2], const Unit& u, const Unit& nx, bool has_next, int wr, int wc, int fr, int fq) const {
        const int pm = u.pm, pn = u.pn; const bool samp = pm >= MP / BM;
        const int ch0 = pn * 128 + wc * 32 + 8 * fq;
        PG8_LAS float* Wc = W + (u.idx & 1) * 1024; PG8_LAS float* Wn = W + ((u.idx + 1) & 1) * 1024;
        const int tw = wc * 64 + fq * 16 + fr, warr = tw >> 5, wc4 = tw & 31;
        const float* wsrc = ((warr & 3) == 3 ? cb : cw + (warr & 3) * NUP) + ((warr >> 2) ? DFF : 0) + 4 * wc4;
        if (wr == 1 && u.idx == 0) *(PG8_LAS f32x4*)(Wc + 4 * tw) = *(const f32x4*)(wsrc + pn * 128);
        f32x4 wnx = (f32x4){0.f, 0.f, 0.f, 0.f};
        if (wr == 1 && has_next) wnx = *(const f32x4*)(wsrc + nx.pn * 128);
        if (fr >= 14) {
#pragma unroll
            for (int ai = 0; ai < 2; ++ai) { PG8_LAS float* xp = X + ((((ai * 2 + wr) * 4 + wc) * 2 + (fr - 14)) * 4 + fq) * 16;
#pragma unroll
                for (int bj = 0; bj < 2; ++bj)
#pragma unroll
                    for (int n = 0; n < 2; ++n) *(PG8_LAS f32x4*)(xp + bj * 8 + n * 4) = acc[ai][bj][3][n]; }
        }
        PG8_EPI_BARRIER();
        float rs[2][4];
#pragma unroll
        for (int ai = 0; ai < 2; ++ai)
#pragma unroll
            for (int m = 0; m < 4; ++m) rs[ai][m] = RS[u.idx * 256 + ai * HALF + wr * 64 + m * 16 + fr];
        const int sq = fr & 3;
#pragma unroll
        for (int n = 0; n < 2; ++n) {
            const int ch = ch0 + 4 * n;
            const PG8_LAS float* wp = Wc + wc * 32 + 8 * fq + 4 * n;
            const f32x4 wa0 = *(const PG8_LAS f32x4*)wp, wa1 = *(const PG8_LAS f32x4*)(wp + 128), wa2 = *(const PG8_LAS f32x4*)(wp + 256), ba = *(const PG8_LAS f32x4*)(wp + 384);
            const f32x4 wb0 = *(const PG8_LAS f32x4*)(wp + 512), wb1 = *(const PG8_LAS f32x4*)(wp + 640), wb2 = *(const PG8_LAS f32x4*)(wp + 768), bb = *(const PG8_LAS f32x4*)(wp + 896);
#pragma unroll
            for (int ai = 0; ai < 2; ++ai) {
                f32x4 pa = (f32x4){0.f, 0.f, 0.f, 0.f}, pb = pa;
                if (wr == 1 || ai == 1) {
                    const int sai = (wr == 1) ? ai : 0, swr = (wr == 1) ? 0 : 1;
                    const PG8_LAS float* xp = X + ((((sai * 2 + swr) * 4 + wc) * 2 + ((fr == 15) ? 1 : 0)) * 4 + fq) * 16 + n * 4;
                    const float prs = RS[u.idx * 256 + ai * HALF + wr * 64 - ((fr == 15) ? 1 : 2)];
                    pa = *(const PG8_LAS f32x4*)xp * prs; pb = *(const PG8_LAS f32x4*)(xp + 8) * prs;
                }
#pragma unroll
                for (int m = 0; m < 4; ++m) {
                    const int row = pm * BM + ai * HALF + wr * 64 + m * 16 + fr;
                    const f32x4 ca = acc[ai][0][m][n] * rs[ai][m], cv = acc[ai][1][m][n] * rs[ai][m];
                    f32x4 p1a, p2a, p1b, p2b;
#pragma unroll
                    for (int e = 0; e < 4; ++e) {
                        p1a[e] = dpp_shr1(dpp_ror1(pa[e]), ca[e]); p2a[e] = dpp_shr2(dpp_ror2(pa[e]), ca[e]);
                        p1b[e] = dpp_shr1(dpp_ror1(pb[e]), cv[e]); p2b[e] = dpp_shr2(dpp_ror2(pb[e]), cv[e]);
                    }
                    if (samp) {
                        const float* sp = st + (size_t)((row - MP) >> 2) * 2 * NUP + ch;
                        if (sq == 0) { p2a = *(const f32x4*)sp; p2b = *(const f32x4*)(sp + DFF); p1a = *(const f32x4*)(sp + NUP); p1b = *(const f32x4*)(sp + NUP + DFF); }
                        else if (sq == 1) { p2a = *(const f32x4*)(sp + NUP); p2b = *(const f32x4*)(sp + NUP + DFF); }
                    }
                    const f32x4 ya = ba + wa0 * p2a + wa1 * p1a + wa2 * ca, yb = bb + wb0 * p2b + wb1 * p1b + wb2 * cv;
                    const bool first2 = (ai == 0 && wr == 0 && m == 0 && fr < 2), last2 = (ai == 1 && wr == 1 && m == 3 && fr >= 14);
                    if (!(first2 && !samp && (pm & 15) != 0)) {
                        u32x2 ov; ov.x = pk2(silu_f(ya[0]) * yb[0], silu_f(ya[1]) * yb[1]); ov.y = pk2(silu_f(ya[2]) * yb[2], silu_f(ya[3]) * yb[3]);
                        *(u32x2*)(ACT + (size_t)row * DFF + ch) = ov;
                    }
                    if (first2) { float* up = U0 + (size_t)(pm * 2 + fr) * NUP + ch; *(f32x4*)up = ca; *(f32x4*)(up + DFF) = cv; }
                    if (last2) { float* up = UL + (size_t)(pm * 2 + fr - 14) * NUP + ch; *(f32x4*)up = ca; *(f32x4*)(up + DFF) = cv;
                        if (!samp && (pm & 15) == 15) { float* op = outp + (size_t)((pm >> 4) * 2 + fr - 14) * NUP + ch; *(f32x4*)op = ca; *(f32x4*)(op + DFF) = cv; } }
                    if (samp && sq >= 2) { float* op = outs + (size_t)(((row - MP) >> 2) * 2 + sq - 2) * NUP + ch; *(f32x4*)op = ca; *(f32x4*)(op + DFF) = cv; }
                    pa = ca; pb = cv;
                    asm volatile("" ::: "memory");
                }
            }
        }
        if (wr == 1 && has_next) *(PG8_LAS f32x4*)(Wn + 4 * tw) = wnx;
    }
};
struct EpiResid {
    static constexpr bool PERM = true, AFTER_DRAIN = false, NEEDS_RSTD = false, WANTS_NEXT = false;
    bf16_t* XB; float* part;
    __device__ __forceinline__ void operator()(const f32x4 (&acc)[2][2][4][2], const Unit& u, int wr, int wc, int fr, int fq) const {
        const int row0 = u.pm * BM + wr * 64 + fr, col0 = u.pn * BM + wc * 32 + 8 * fq;
#pragma unroll
        for (int ai = 0; ai < 2; ++ai)
#pragma unroll
            for (int m = 0; m < 4; ++m) {
                const int row = row0 + ai * HALF + m * 16;
                float ss = 0.f;
#pragma unroll
                for (int bj = 0; bj < 2; ++bj) { bf16_t* xp = XB + (size_t)row * DM + col0 + bj * HALF;
                    float o[8]; unpack8(*(const u32x4*)xp, o);
                    const f32x4 v0 = (f32x4){o[0], o[1], o[2], o[3]} + acc[ai][bj][m][0], v1 = (f32x4){o[4], o[5], o[6], o[7]} + acc[ai][bj][m][1];
                    ss += (v0[0] * v0[0] + v0[1] * v0[1]) + (v0[2] * v0[2] + v0[3] * v0[3]) + (v1[0] * v1[0] + v1[1] * v1[1]) + (v1[2] * v1[2] + v1[3] * v1[3]);
                    u32x4 w; w.x = pk2(v0[0], v0[1]); w.y = pk2(v0[2], v0[3]); w.z = pk2(v1[0], v1[1]); w.w = pk2(v1[2], v1[3]);
                    *(u32x4*)xp = w; }
                ss += __shfl_xor(ss, 16); ss += __shfl_xor(ss, 32);
                if (fq == 0) part[(size_t)row * 16 + u.pn * 4 + wc] = ss;
            }
    }
};

template <class Epi, class Sched, bool ALIGN_EPI = false, bool SP2 = false>
__device__ __forceinline__ void gemm_phase(PG8_LAS unsigned char* lds, const Gemm g, const Sched& S, const Epi& E) {
    const int tid = threadIdx.x, wid = __builtin_amdgcn_readfirstlane(tid >> 6), lane = tid & 63, wr = wid >> 2, wc = wid & 3, fr = lane & 15, fq = lane >> 4;
    const int K = g.K, nt = K / BK;
    unsigned voffA[2], voffB[2];
#pragma unroll
    for (int i = 0; i < 2; ++i) { int R, C; stage_rc(tid * 16 + i * 8192, R, C); const int Rb = Epi::PERM ? ((R & ~31) + perm32(R & 31)) : R;
        voffA[i] = (unsigned)(R * K + C) * 2u; voffB[i] = (unsigned)(Rb * K + C) * 2u; }
    const size_t kstep = (size_t)(BK * 2);
    const size_t hstep = (size_t)HALF * K * 2;
    const size_t tstep = 2 * hstep;
    const unsigned ldsw = (unsigned)wid * 1024u;
    const int aoff = lds_byte(wr * 64 + fr, fq * 8), boff = lds_byte(wc * 32 + fr, fq * 8);
#define PG8_SA(b, h) (((b) * 2 + (h)) * HTB)
#define PG8_SB(b, h) ((4 + (b) * 2 + (h)) * HTB)
#define PG8_STAGE(bufoff, gbase, voff) do { _Pragma("unroll") for (int _i = 0; _i < 2; ++_i) \
        __builtin_amdgcn_global_load_lds((const unsigned*)((const char*)(gbase) + (voff)[_i]), (PG8_LAS unsigned*)(lds + (bufoff) + ldsw + _i * 8192), 16, 0, 0); } while (0)
#define PG8_LDA(dst, b, h) do { _Pragma("unroll") for (int m = 0; m < 4; ++m) _Pragma("unroll") for (int k = 0; k < 2; ++k) dst[m][k] = *(const PG8_LAS bf16x8*)(lds + PG8_SA(b, h) + aoff + m * 2048 + k * 1024); } while (0)
#define PG8_LDB(dst, b, h) do { _Pragma("unroll") for (int n = 0; n < 2; ++n) _Pragma("unroll") for (int k = 0; k < 2; ++k) dst[n][k] = *(const PG8_LAS bf16x8*)(lds + PG8_SB(b, h) + boff + n * 2048 + k * 1024); } while (0)
#define PG8_MMA(ai, bj, At, Bt) do { __builtin_amdgcn_s_setprio(1); _Pragma("unroll") for (int m = 0; m < 4; ++m) _Pragma("unroll") for (int n = 0; n < 2; ++n) _Pragma("unroll") for (int k = 0; k < 2; ++k) \
        acc[ai][bj][m][n] = __builtin_amdgcn_mfma_f32_16x16x32_bf16(Bt[n][k], At[m][k], acc[ai][bj][m][n], 0, 0, 0); __builtin_amdgcn_s_setprio(0); } while (0)
#define PG8_WAIT_V(n) asm volatile("s_waitcnt vmcnt(" #n ")" ::: "memory")
#define PG8_WAIT_L(n) asm volatile("s_waitcnt lgkmcnt(" #n ")" ::: "memory")
#define PG8_BAR __builtin_amdgcn_s_barrier()
#define PG8_SCHED __builtin_amdgcn_sched_barrier(0)
    Unit cur, nxt; int ui = 0;
    if (!S.next(0, cur)) return;
    f32x4 acc[2][2][4][2];
#pragma unroll
    for (int a = 0; a < 2; ++a)
#pragma unroll
        for (int b = 0; b < 2; ++b)
#pragma unroll
            for (int m = 0; m < 4; ++m)
#pragma unroll
                for (int n = 0; n < 2; ++n) acc[a][b][m][n] = (f32x4){0.f, 0.f, 0.f, 0.f};
    bf16x8 At[4][2], B0[2][2], B1[2][2];
    const char* cA = (const char*)g.A + (size_t)cur.pm * tstep; const char* cB = (const char*)g.Bt + (size_t)cur.pn * tstep;
    S.a_ready(cur);
    if constexpr (SP2) {
        PG8_STAGE(PG8_SB(0, 0), cB, voffB); PG8_STAGE(PG8_SB(0, 1), cB + hstep, voffB); PG8_STAGE(PG8_SA(0, 0), cA, voffA); PG8_STAGE(PG8_SA(0, 1), cA + hstep, voffA);
        if (wr == 1) PG8_BAR;
        PG8_WAIT_V(2); PG8_BAR;
        PG8_STAGE(PG8_SB(1, 0), cB + kstep, voffB); PG8_STAGE(PG8_SA(1, 0), cA + kstep, voffA); PG8_STAGE(PG8_SB(1, 1), cB + hstep + kstep, voffB);
        PG8_WAIT_V(6); PG8_BAR;
    } else {
        PG8_STAGE(PG8_SB(0, 0), cB, voffB); PG8_STAGE(PG8_SA(0, 0), cA, voffA); PG8_STAGE(PG8_SB(0, 1), cB + hstep, voffB); PG8_STAGE(PG8_SA(0, 1), cA + hstep, voffA);
        if (wr == 1) PG8_BAR;
        PG8_WAIT_V(4); PG8_BAR;
        PG8_STAGE(PG8_SB(1, 0), cB + kstep, voffB); PG8_STAGE(PG8_SA(1, 0), cA + kstep, voffA); PG8_STAGE(PG8_SB(1, 1), cB + hstep + kstep, voffB);
        PG8_WAIT_V(6); PG8_BAR;
    }
    for (;;) {
        const bool has_next = S.next(ui + 1, nxt);
        const char* nA = has_next ? (const char*)g.A + (size_t)nxt.pm * tstep : cA; const char* nB = has_next ? (const char*)g.Bt + (size_t)nxt.pn * tstep : cB;
        for (int t = 0; t < nt; t += 2) {
            const bool last = (t == nt - 2);
            const char* a1 = cA + (size_t)(t + 1) * kstep;
            const char* a2 = last ? nA : cA + (size_t)(t + 2) * kstep; const char* b2 = last ? nB : cB + (size_t)(t + 2) * kstep;
            const char* a3 = a2 + kstep; const char* b3 = b2 + kstep;
            if (last && has_next) S.a_ready(nxt);
            if constexpr (SP2) {
            PG8_LDB(B0, 0, 0); PG8_LDB(B1, 0, 1); PG8_SCHED; PG8_LDA(At, 0, 0); PG8_STAGE(PG8_SA(1, 1), a1 + hstep, voffA);
            PG8_WAIT_V(8); PG8_WAIT_L(0); PG8_BAR; PG8_MMA(0, 0, At, B0); PG8_MMA(0, 1, At, B1); PG8_BAR; PG8_SCHED;
            PG8_LDA(At, 0, 1); PG8_STAGE(PG8_SB(0, 0), b2, voffB); PG8_STAGE(PG8_SB(0, 1), b2 + hstep, voffB); PG8_STAGE(PG8_SA(0, 0), a2, voffA);
            PG8_WAIT_V(8); PG8_WAIT_L(0); PG8_BAR; PG8_MMA(1, 0, At, B0); PG8_MMA(1, 1, At, B1); PG8_BAR; PG8_SCHED;
            PG8_LDB(B0, 1, 0); PG8_LDB(B1, 1, 1); PG8_SCHED; PG8_LDA(At, 1, 0); PG8_STAGE(PG8_SA(0, 1), a2 + hstep, voffA);
            PG8_WAIT_V(8); PG8_WAIT_L(0); PG8_BAR; PG8_MMA(0, 0, At, B0); PG8_MMA(0, 1, At, B1); PG8_BAR; PG8_SCHED;
            PG8_LDA(At, 1, 1); PG8_STAGE(PG8_SB(1, 0), b3, voffB); PG8_STAGE(PG8_SB(1, 1), b3 + hstep, voffB); PG8_STAGE(PG8_SA(1, 0), a3, voffA);
            PG8_WAIT_V(8); PG8_WAIT_L(0); PG8_BAR; PG8_MMA(1, 0, At, B0); PG8_MMA(1, 1, At, B1); PG8_BAR; PG8_SCHED;
            } else {
            PG8_LDB(B0, 0, 0); PG8_SCHED; PG8_LDA(At, 0, 0); PG8_STAGE(PG8_SA(1, 1), a1 + hstep, voffA);
            PG8_WAIT_L(8); PG8_BAR; PG8_WAIT_L(0); PG8_MMA(0, 0, At, B0); PG8_BAR; PG8_SCHED;
            PG8_LDB(B1, 0, 1); PG8_STAGE(PG8_SB(0, 0), b2, voffB);
            PG8_BAR; PG8_WAIT_L(0); PG8_MMA(0, 1, At, B1); PG8_BAR;
            PG8_LDA(At, 0, 1); PG8_STAGE(PG8_SA(0, 0), a2, voffA);
            PG8_BAR; PG8_WAIT_L(0); PG8_MMA(1, 0, At, B0); PG8_BAR; PG8_SCHED;
            PG8_STAGE(PG8_SB(0, 1), b2 + hstep, voffB);
            PG8_WAIT_V(6); PG8_BAR; PG8_MMA(1, 1, At, B1); PG8_BAR;
            PG8_LDB(B0, 1, 0); PG8_SCHED; PG8_LDA(At, 1, 0); PG8_STAGE(PG8_SA(0, 1), a2 + hstep, voffA);
            PG8_WAIT_L(8); PG8_BAR; PG8_WAIT_L(0); PG8_MMA(0, 0, At, B0); PG8_BAR; PG8_SCHED;
            PG8_LDB(B1, 1, 1); PG8_STAGE(PG8_SB(1, 0), b3, voffB);
            PG8_BAR; PG8_WAIT_L(0); PG8_MMA(0, 1, At, B1); PG8_BAR;
            PG8_LDA(At, 1, 1); PG8_STAGE(PG8_SA(1, 0), a3, voffA);
            PG8_BAR; PG8_WAIT_L(0); PG8_MMA(1, 0, At, B0); PG8_BAR; PG8_SCHED;
            PG8_STAGE(PG8_SB(1, 1), b3 + hstep, voffB);
            PG8_WAIT_V(6); PG8_BAR; PG8_MMA(1, 1, At, B1); PG8_BAR;
            }
        }
        if constexpr (ALIGN_EPI) { if (wr == 0) PG8_BAR; }
        if constexpr (!Epi::AFTER_DRAIN) { if constexpr (Epi::WANTS_NEXT) E(acc, cur, nxt, has_next, wr, wc, fr, fq); else E(acc, cur, wr, wc, fr, fq); S.done(cur); }
        if (!has_next) break;
#pragma unroll
        for (int a = 0; a < 2; ++a)
#pragma unroll
            for (int b = 0; b < 2; ++b)
#pragma unroll
                for (int m = 0; m < 4; ++m)
#pragma unroll
                    for (int n = 0; n < 2; ++n) acc[a][b][m][n] = (f32x4){0.f, 0.f, 0.f, 0.f};
        cur = nxt; cA = nA; cB = nB; ++ui;
        if constexpr (ALIGN_EPI) { if (wr == 1) PG8_BAR; }
    }
    PG8_WAIT_V(0);
    if constexpr (!ALIGN_EPI) { if (wr == 0) PG8_BAR; }
    PG8_BAR;
    if constexpr (Epi::AFTER_DRAIN) { E.fused(acc, cur, wr, wc, fr, fq, lds, wid, lane); S.done(cur); }
#undef PG8_SA
#undef PG8_SB
#undef PG8_STAGE
#undef PG8_LDA
#undef PG8_LDB
#undef PG8_MMA
#undef PG8_WAIT_V
#undef PG8_WAIT_L
#undef PG8_BAR
#undef PG8_SCHED
}
}

constexpr int NWAVES = 8, NTHREADS = 512;
constexpr int RING_BYTES = 131072, LDS_BYTES = 159744, LDSCTL_OFF = 158720;
struct Args { const float* in[26]; float* out; unsigned char* ws; int ph_lo, ph_hi, coop, pad; };
struct Ctx {
    const float* in[26]; float* out; unsigned char* ws; LAS unsigned char* lds; int tid, lane, wave, G, bid;
    float *PART, *BIASD, *CDEC, *DTRAW, *U0, *UL; bf16_t *WQKV, *WO, *WIN, *WOUT, *WUP, *WDN, *XB, *QKV, *AO, *ACT, *Z, *XBC, *ST, *HP, *XC;
};
enum { I_XP = 0, I_XS, I_CK, I_CV, I_SCONV, I_SSSM, I_SFFN, I_RELB, I_NMIX, I_NFFN, I_NFIN, I_WQKV, I_WO, I_SINK, I_WIN, I_CW, I_CB, I_DTB, I_ALOG, I_SD, I_SNORM, I_WOUT, I_WUP, I_FCW, I_FCB, I_WDN };

__device__ __forceinline__ int t5_bucket(int n) {
    if (n < 16) return n;
    int b = 16;
    b += (n >= 19); b += (n >= 21); b += (n >= 24); b += (n >= 27); b += (n >= 31); b += (n >= 35); b += (n >= 40); b += (n >= 46); b += (n >= 52); b += (n >= 59); b += (n >= 67); b += (n >= 77); b += (n >= 87); b += (n >= 99); b += (n >= 113);
    return b;
}

template <bool UPPERM> __device__ __forceinline__ void p0_transpose_item(const float* W, int K, int N, bf16_t* WT, const float* gain, LAS float* scr, int item, int lane) {
    const int nblk = N / 32, kb = item / nblk, nb = item % nblk, k0 = 64 * kb, n0 = 32 * nb;
    f32x4 ld[8];
#pragma unroll
    for (int i = 0; i < 8; ++i) ld[i] = *(const f32x4*)(W + (size_t)(k0 + 8 * i + (lane >> 3)) * N + n0 + 4 * (lane & 7));
#pragma unroll
    for (int i = 0; i < 8; ++i) { const int kk = 8 * i + (lane >> 3); f32x4 v = ld[i]; if (gain) v = v * gain[k0 + kk];
        LAS float* d = scr + kk * 33 + 4 * (lane & 7); d[0] = v.x; d[1] = v.y; d[2] = v.z; d[3] = v.w; }
    asm volatile("s_waitcnt lgkmcnt(0)" ::: "memory");
    const int c = lane & 7;
#pragma unroll
    for (int j = 0; j < 4; ++j) { const int n = (lane >> 3) + 8 * j; const LAS float* s = scr + (8 * c) * 33 + n;
        u32x4 o; o.x = pk2(s[0 * 33], s[1 * 33]); o.y = pk2(s[2 * 33], s[3 * 33]); o.z = pk2(s[4 * 33], s[5 * 33]); o.w = pk2(s[6 * 33], s[7 * 33]);
        int dr = n0 + n;
        if (UPPERM) dr = (dr < DFF) ? ((dr >> 7) * 256 + (dr & 127)) : (((dr - DFF) >> 7) * 256 + 128 + ((dr - DFF) & 127));
        *(u32x4*)(WT + (size_t)dr * K + k0 + 8 * c) = o; }
    asm volatile("s_waitcnt lgkmcnt(0)" ::: "memory");
}
template <int GRP> __device__ __forceinline__ void convert_group(const Ctx& C, int gw, int NGW) {
    LAS float* scr = (LAS float*)(C.lds + C.wave * 16384);
    constexpr int I0 = (DM / 64) * (NQKV / 32), I1 = (DM / 64) * (DM / 32), I2 = (DM / 64) * (NIN / 32), I3 = (DIN / 64) * (DM / 32), I4 = (DM / 64) * (NUP / 32), I5 = (DFF / 64) * (DM / 32);
    if (GRP == 0) for (int it = gw; it < I0; it += NGW) p0_transpose_item<false>(C.in[I_WQKV], DM, NQKV, C.WQKV, C.in[I_NMIX], scr, it, C.lane);
    if (GRP == 1) for (int it = gw; it < I1 + I4; it += NGW) {
        if (it < I1) p0_transpose_item<false>(C.in[I_WO], DM, DM, C.WO, nullptr, scr, it, C.lane);
        else p0_transpose_item<true>(C.in[I_WUP], DM, NUP, C.WUP, C.in[I_NFFN], scr, it - I1, C.lane); }
    if (GRP == 2) {
        for (int it = gw; it < I5 + I2; it += NGW) {
            if (it < I5) p0_transpose_item<false>(C.in[I_WDN], DFF, DM, C.WDN, nullptr, scr, it, C.lane);
            else p0_transpose_item<false>(C.in[I_WIN], DM, NIN, C.WIN, C.in[I_NMIX] + DM, scr, it - I5, C.lane); }
        u32x4* z = (u32x4*)(C.WIN + (size_t)NIN * DM);
        for (int i = gw * 64 + C.lane; i < (NINP - NIN) * DM / 8; i += NGW * 64) z[i] = (u32x4){0u, 0u, 0u, 0u};
    }
    if (GRP == 3) for (int it = gw; it < I3 + I4; it += NGW) {
        if (it < I3) p0_transpose_item<false>(C.in[I_WOUT], DIN, DM, C.WOUT, C.in[I_SNORM], scr, it, C.lane);
        else p0_transpose_item<true>(C.in[I_WUP] + (size_t)DM * NUP, DM, NUP, C.WUP + (size_t)NUP * DM, C.in[I_NFFN] + DM, scr, it - I3, C.lane); }
    if (GRP == 4) for (int it = gw; it < I5; it += NGW) p0_transpose_item<false>(C.in[I_WDN] + (size_t)DFF * DM, DFF, DM, C.WDN + (size_t)DM * DFF, nullptr, scr, it, C.lane);
}
template <int GRP> __device__ __forceinline__ void convert_in_tail(const Ctx& C, int nwg) {
    const int r = nwg % C.G;
    if (C.bid >= r) convert_group<GRP>(C, (C.bid - r) * NWAVES + C.wave, (C.G - r) * NWAVES);
    __syncthreads();
}
__device__ __forceinline__ void phase_prologue(const Ctx& C) {
    const int gw = C.bid * NWAVES + C.wave, NGW = C.G * NWAVES;
    convert_group<0>(C, gw, NGW);
    for (int m = gw; m < MT; m += NGW) {
        const float* xrow = (m < MP) ? C.in[I_XP] + (size_t)m * DM : C.in[I_XS] + (size_t)(m - MP) * DM;
        const f32x4* xr = (const f32x4*)xrow + 2 * C.lane; f32x4 v[4]; float s = 0.f;
#pragma unroll
        for (int j = 0; j < 4; ++j) { v[j] = xr[128 * (j >> 1) + (j & 1)]; s += (v[j].x * v[j].x + v[j].y * v[j].y) + (v[j].z * v[j].z + v[j].w * v[j].w); }
        s = wave_sum(s);
        u32x4* o16 = (u32x4*)(C.XB + (size_t)m * DM) + C.lane;
#pragma unroll
        for (int j = 0; j < 2; ++j) { u32x4 w; w.x = pk2(v[2 * j].x, v[2 * j].y); w.y = pk2(v[2 * j].z, v[2 * j].w); w.z = pk2(v[2 * j + 1].x, v[2 * j + 1].y); w.w = pk2(v[2 * j + 1].z, v[2 * j + 1].w); o16[64 * j] = w; }
        if (C.lane < 16) C.PART[(size_t)m * 16 + C.lane] = (C.lane == 0) ? s : 0.f;
    }
    { const int gt = C.bid * NTHREADS + C.tid; if (gt < 16 * 128) { const int h = gt >> 7, d = gt & 127; C.BIASD[gt] = C.in[I_RELB][t5_bucket(d) * 16 + h] * LOG2E; } }
}

#define MFMA32(a, b, c) __builtin_amdgcn_mfma_f32_32x32x16_bf16((a), (b), (c), 0, 0, 0)
typedef short v4i16_t __attribute__((ext_vector_type(4)));
__device__ __forceinline__ s16x4 lds_tr4(const LAS bf16_t* p) { return __builtin_bit_cast(s16x4, __builtin_amdgcn_ds_read_tr16_b64_v4i16((LAS v4i16_t*)p)); }
__device__ __forceinline__ bf16x8 cat8(s16x4 a, s16x4 b) { return (bf16x8){a[0], a[1], a[2], a[3], b[0], b[1], b[2], b[3]}; }
__device__ __forceinline__ f32x16 zero16() { f32x16 z; for (int i = 0; i < 16; ++i) z[i] = 0.f; return z; }

__device__ __forceinline__ void attn_prompt_unit(const Ctx& C, int b, int c, int g) {
    LAS bf16_t* Ks = (LAS bf16_t*)C.lds;
    LAS bf16_t* Vt = (LAS bf16_t*)(C.lds + 36864);
    LAS float* Bd = (LAS float*)(C.lds + 36864 + 33792);
    const int tid = C.tid, lane = C.lane, w = C.wave;
    const bf16_t* qbase = C.QKV + (size_t)(b * SEQ + c * 128 + (w & 1) * 64 + (lane & 31)) * NQKV + (g * 4 + (w >> 1)) * 64 + 8 * (lane >> 5);
    bf16x8 qn[4];
#pragma unroll
    for (int s = 0; s < 4; ++s) qn[s] = *(const bf16x8*)(qbase + 16 * s);
#pragma unroll
    for (int i = 0; i < 4; ++i) {
        const int id = i * NTHREADS + tid, row = id >> 3, ch = id & 7, kpos = (c - 1) * 128 + row;
        u32x4 kv = (u32x4){0u, 0u, 0u, 0u}, vv = (u32x4){0u, 0u, 0u, 0u};
        if (kpos >= 0) { const bf16_t* src = C.QKV + (size_t)(b * SEQ + kpos) * NQKV + 1024 + g * 64 + ch * 8; kv = *(const u32x4*)src; vv = *(const u32x4*)(src + 256); }
        *(LAS u32x4*)(Ks + row * 72 + ch * 8) = kv;
        const int prow = (row & ~15) | ((row & 3) + 4 * ((row >> 3) & 1) + 8 * ((row >> 2) & 1));
        LAS bf16_t* vd = Vt + (ch * 8) * 264 + prow;
        vd[0 * 264] = (bf16_t)(vv.x & 0xffffu); vd[1 * 264] = (bf16_t)(vv.x >> 16); vd[2 * 264] = (bf16_t)(vv.y & 0xffffu); vd[3 * 264] = (bf16_t)(vv.y >> 16);
        vd[4 * 264] = (bf16_t)(vv.z & 0xffffu); vd[5 * 264] = (bf16_t)(vv.z >> 16); vd[6 * 264] = (bf16_t)(vv.w & 0xffffu); vd[7 * 264] = (bf16_t)(vv.w >> 16);
    }
    Bd[tid] = C.BIASD[(g * 4 + (tid >> 7)) * 128 + (tid & 127)];
    __syncthreads();
    const int r = w >> 1, ph = w & 1, hh = g * 4 + r, ql = lane & 31, hi = lane >> 5;
    const float sink2 = C.in[I_SINK][hh] * LOG2E;
    const int jmin = (c == 0) ? 128 : 0;
    for (int qg = 0; qg < 2; ++qg) {
        const int q0 = ph * 64 + qg * 32, qi = q0 + ql, t0 = q0 >> 5;
        const size_t qrow = (size_t)(b * SEQ + c * 128 + qi);
        bf16x8 qf[4];
#pragma unroll
        for (int s = 0; s < 4; ++s) qf[s] = qn[s];
        if (qg == 0) {
#pragma unroll
            for (int s = 0; s < 4; ++s) qn[s] = *(const bf16x8*)(qbase + (size_t)32 * NQKV + 16 * s); }
        f32x16 S[5];
#pragma unroll
        for (int kk = 0; kk < 5; ++kk) {
            S[kk] = zero16();
#pragma unroll
            for (int s = 0; s < 4; ++s) { const bf16x8 kf = *(const LAS bf16x8*)(Ks + (32 * (t0 + kk) + ql) * 72 + 16 * s + 8 * hi); S[kk] = MFMA32(kf, qf[s], S[kk]); }
        }
        float mx = sink2; const int dbase = qi + 128 - 32 * t0;
        const LAS float* bdp = Bd + r * 128 + ql - 32 - 4 * hi;
#pragma unroll
        for (int kk = 0; kk < 5; ++kk)
#pragma unroll
            for (int rr = 0; rr < 16; ++rr) {
                const int jl = 32 * kk + crow(rr, hi), d = dbase - jl, j = 32 * t0 + jl;
                if ((rr & 7) == 0) asm volatile("" ::: "memory");
                float v = S[kk][rr] * (0.125f * LOG2E) + bdp[160 - 32 * kk - (rr & 3) - 8 * (rr >> 2)];
                if (kk == 0 || kk == 4 || c == 0) { const bool ok = (d >= 0) && (d < 128) && (j >= jmin); v = ok ? v : -INFINITY; }
                S[kk][rr] = v; mx = fmaxf(mx, v);
            }
        mx = fmaxf(mx, __shfl_xor(mx, 32));
        float l = 0.f;
#pragma unroll
        for (int kk = 0; kk < 5; ++kk)
#pragma unroll
            for (int rr = 0; rr < 16; ++rr) { const float p = __builtin_amdgcn_exp2f(S[kk][rr] - mx); S[kk][rr] = p; l += p; }
        l += __shfl_xor(l, 32); l += __builtin_amdgcn_exp2f(sink2 - mx);
        const float inv = 1.0f / l;
        f32x16 O[2]; O[0] = zero16(); O[1] = zero16();
#pragma unroll
        for (int kk = 0; kk < 5; ++kk)
#pragma unroll
            for (int ks = 0; ks < 2; ++ks) {
                u32x4 pw; pw.x = pk2(S[kk][8 * ks + 0], S[kk][8 * ks + 1]); pw.y = pk2(S[kk][8 * ks + 2], S[kk][8 * ks + 3]); pw.z = pk2(S[kk][8 * ks + 4], S[kk][8 * ks + 5]); pw.w = pk2(S[kk][8 * ks + 6], S[kk][8 * ks + 7]);
                const bf16x8 pf = __builtin_bit_cast(bf16x8, pw);
#pragma unroll
                for (int dt = 0; dt < 2; ++dt) { const bf16x8 vf = *(const LAS bf16x8*)(Vt + (32 * dt + ql) * 264 + 32 * (t0 + kk) + 16 * ks + 8 * hi); O[dt] = MFMA32(vf, pf, O[dt]); }
            }
#pragma unroll
        for (int dt = 0; dt < 2; ++dt)
#pragma unroll
            for (int q4 = 0; q4 < 4; ++q4) {
                u32x2 wv; wv.x = pk2(O[dt][4 * q4] * inv, O[dt][4 * q4 + 1] * inv); wv.y = pk2(O[dt][4 * q4 + 2] * inv, O[dt][4 * q4 + 3] * inv);
                *(u32x2*)(C.AO + qrow * DM + hh * 64 + 32 * dt + 8 * q4 + 4 * hi) = wv;
            }
    }
    if (c == NCHUNK - 1) {
#pragma unroll
        for (int i = 0; i < 2; ++i) {
            const int id = i * NTHREADS + tid, wq = id >> 3, ch = id & 7;
            const bf16_t* src = C.QKV + (size_t)(b * SEQ + SEQ - 128 + wq) * NQKV + 1024 + g * 64 + ch * 8;
            float kf[8], vf[8]; unpack8(*(const u32x4*)src, kf); unpack8(*(const u32x4*)(src + 256), vf);
            float* ok = C.out + O_PK + ((size_t)(b * 128 + wq) * 4 + g) * 64 + ch * 8; float* ov = C.out + O_PV + ((size_t)(b * 128 + wq) * 4 + g) * 64 + ch * 8;
            *(f32x4*)ok = (f32x4){kf[0], kf[1], kf[2], kf[3]}; *(f32x4*)(ok + 4) = (f32x4){kf[4], kf[5], kf[6], kf[7]};
            *(f32x4*)ov = (f32x4){vf[0], vf[1], vf[2], vf[3]}; *(f32x4*)(ov + 4) = (f32x4){vf[4], vf[5], vf[6], vf[7]};
        }
    }
    __syncthreads();
}
__device__ __forceinline__ void attn_sample_unit(const Ctx& C, int b, int g) {
    constexpr int KP = 72, VP = 168, PSP = 148;
    LAS bf16_t* Kb = (LAS bf16_t*)C.lds;
    LAS bf16_t* Vt = Kb + 144 * KP;
    LAS bf16_t* Qb = Vt + 64 * VP;
    LAS float* Ps = (LAS float*)(Qb + 16 * KP);
    LAS bf16_t* Pb = (LAS bf16_t*)(Ps + 16 * PSP);
    LAS float* Bd2 = (LAS float*)(Pb + 16 * VP);
    int tid = (int)threadIdx.x; asm volatile("" : "+v"(tid));
    const int lane = tid & 63, w = C.wave, j16 = lane & 15, iq = lane >> 4;
    const float* ck = C.in[I_CK]; const float* cv = C.in[I_CV];
#pragma unroll
    for (int i = 0; i < 4; ++i) {
        const int id = i * NTHREADS + tid, wq = id >> 4, ch = id & 15; const size_t off = ((size_t)(b * 128 + wq) * 4 + g) * 64 + ch * 4;
        const f32x4 kv = *(const f32x4*)(ck + off), vv = *(const f32x4*)(cv + off);
        u32x2 kw; kw.x = pk2(kv.x, kv.y); kw.y = pk2(kv.z, kv.w); *(LAS u32x2*)(Kb + wq * KP + ch * 4) = kw;
        const unsigned v01 = pk2(vv.x, vv.y), v23 = pk2(vv.z, vv.w); LAS bf16_t* vd = Vt + (ch * 4) * VP + wq;
        vd[0] = (bf16_t)(v01 & 0xffffu); vd[VP] = (bf16_t)(v01 >> 16); vd[2 * VP] = (bf16_t)(v23 & 0xffffu); vd[3 * VP] = (bf16_t)(v23 >> 16);
        if (wq >= 4) { const size_t oo = ((size_t)(b * 128 + wq - 4) * 4 + g) * 64 + ch * 4; *(f32x4*)(C.out + O_SK + oo) = kv; *(f32x4*)(C.out + O_SV + oo) = vv; }
    }
    { const int isv = tid >> 8, s = (tid >> 6) & 3, d = tid & 63;
      const bf16_t raw = C.QKV[(size_t)(MP + b * 4 + s) * NQKV + 1024 + isv * 256 + g * 64 + d];
      if (isv) Vt[d * VP + 128 + s] = raw; else Kb[(128 + s) * KP + d] = raw;
      C.out[(isv ? O_SV : O_SK) + ((size_t)(b * 128 + 124 + s) * 4 + g) * 64 + d] = bf2f((unsigned short)raw); }
    if (tid < 96) *(LAS u32x4*)(Kb + (132 + (tid >> 3)) * KP + (tid & 7) * 8) = (u32x4){0u, 0u, 0u, 0u};
    if (tid < 448) { const int row = tid / 7, k = 132 + (tid % 7) * 4; *(LAS u32x2*)(Vt + row * VP + k) = (u32x2){0u, 0u}; }
    if (tid >= 384) { const int t = tid - 384, qr = t >> 3, ch = t & 7, r = qr >> 2, s = qr & 3;
      *(LAS u32x4*)(Qb + qr * KP + ch * 8) = *(const u32x4*)(C.QKV + (size_t)(MP + b * 4 + s) * NQKV + (g * 4 + r) * 64 + ch * 8); }
    Bd2[tid] = C.BIASD[(g * 4 + (tid >> 7)) * 128 + (tid & 127)];
    __syncthreads();
    for (int nt = w; nt < 9; nt += NWAVES) {
        f32x4 acc = (f32x4){0.f, 0.f, 0.f, 0.f};
#pragma unroll
        for (int ks = 0; ks < 2; ++ks) { const bf16x8 qf = *(const LAS bf16x8*)(Qb + j16 * KP + 32 * ks + 8 * iq), kf = *(const LAS bf16x8*)(Kb + (16 * nt + j16) * KP + 32 * ks + 8 * iq);
            acc = __builtin_amdgcn_mfma_f32_16x16x32_bf16(qf, kf, acc, 0, 0, 0); }
        const int key = 16 * nt + j16;
#pragma unroll
        for (int s = 0; s < 4; ++s) { const int dist = 128 + s - key; const bool ok = (dist >= 0) && (dist < 128);
            Ps[(iq * 4 + s) * PSP + key] = ok ? acc[s] * (0.125f * LOG2E) + Bd2[iq * 128 + (dist & 127)] : -INFINITY; }
    }
    __syncthreads();
#pragma unroll
    for (int qq = 0; qq < 2; ++qq) {
        const int qr = 2 * w + qq, r = qr >> 2; const float sink2 = C.in[I_SINK][g * 4 + r] * LOG2E;
        const LAS float* pr = Ps + qr * PSP; LAS bf16_t* pb = Pb + qr * VP;
        const float v0 = pr[lane], v1 = pr[64 + lane], v2 = (lane < 4) ? pr[128 + lane] : -INFINITY;
        const float mx = fmaxf(wave_max(fmaxf(fmaxf(v0, v1), v2)), sink2);
        const float p0 = __builtin_amdgcn_exp2f(v0 - mx), p1 = __builtin_amdgcn_exp2f(v1 - mx), p2 = __builtin_amdgcn_exp2f(v2 - mx);
        const float l = wave_sum(p0 + p1 + p2) + __builtin_amdgcn_exp2f(sink2 - mx), inv = 1.0f / l;
        pb[lane] = (bf16_t)(pk2(p0 * inv, 0.f) & 0xffffu); pb[64 + lane] = (bf16_t)(pk2(p1 * inv, 0.f) & 0xffffu);
        if (lane < 32) pb[128 + lane] = (bf16_t)(pk2(p2 * inv, 0.f) & 0xffffu);
    }
    __syncthreads();
    if (w < 4) {
        f32x4 acc = (f32x4){0.f, 0.f, 0.f, 0.f};
#pragma unroll
        for (int ks = 0; ks < 5; ++ks) { const bf16x8 vf = *(const LAS bf16x8*)(Vt + (16 * w + j16) * VP + 32 * ks + 8 * iq), pf = *(const LAS bf16x8*)(Pb + j16 * VP + 32 * ks + 8 * iq);
            acc = __builtin_amdgcn_mfma_f32_16x16x32_bf16(vf, pf, acc, 0, 0, 0); }
        const int r = j16 >> 2, s = j16 & 3;
        u32x2 ov; ov.x = pk2(acc[0], acc[1]); ov.y = pk2(acc[2], acc[3]);
        *(u32x2*)(C.AO + (size_t)(MP + b * 4 + s) * DM + (g * 4 + r) * 64 + 16 * w + 4 * iq) = ov;
    }
    __syncthreads();
}
__device__ __forceinline__ void phase_attention(const Ctx& C) {
    for (int u = C.bid; u < 1024; u += C.G) {
        if (u < 512) attn_prompt_unit(C, u >> 7, (u >> 2) & 31, u & 3);
        else attn_sample_unit(C, (u - 512) >> 2, u & 3);
    }
}

__device__ __forceinline__ void ffn_fixup_tile(const Ctx& C, int layer, int pm) {
    if ((pm & 15) != 0 && pm < MP / 256) {
        const float* cw = C.in[I_FCW] + (size_t)layer * 3 * NUP; const float* cb = C.in[I_FCB] + (size_t)layer * NUP;
        int t_ = (int)threadIdx.x; asm volatile("" : "+v"(t_));
        for (int id = t_; id < 2 * (DFF / 4); id += NTHREADS) {
            const int k = (id >= DFF / 4) ? 1 : 0, ch = 4 * (id - k * (DFF / 4));
            const float* u0 = C.U0 + (size_t)(pm * 2) * NUP + ch; const float* ul = C.UL + (size_t)((pm - 1) * 2) * NUP + ch;
            const f32x4 ca = *(const f32x4*)(u0 + k * NUP), cv = *(const f32x4*)(u0 + k * NUP + DFF);
            const f32x4 p1a = k ? *(const f32x4*)u0 : *(const f32x4*)(ul + NUP), p1b = k ? *(const f32x4*)(u0 + DFF) : *(const f32x4*)(ul + NUP + DFF);
            const f32x4 p2a = k ? *(const f32x4*)(ul + NUP) : *(const f32x4*)ul, p2b = k ? *(const f32x4*)(ul + NUP + DFF) : *(const f32x4*)(ul + DFF);
            const f32x4 ya = *(const f32x4*)(cb + ch) + *(const f32x4*)(cw + ch) * p2a + *(const f32x4*)(cw + NUP + ch) * p1a + *(const f32x4*)(cw + 2 * NUP + ch) * ca;
            const f32x4 yb = *(const f32x4*)(cb + DFF + ch) + *(const f32x4*)(cw + DFF + ch) * p2b + *(const f32x4*)(cw + NUP + DFF + ch) * p1b + *(const f32x4*)(cw + 2 * NUP + DFF + ch) * cv;
            u32x2 ov; ov.x = pk2(silu_f(ya[0]) * yb[0], silu_f(ya[1]) * yb[1]); ov.y = pk2(silu_f(ya[2]) * yb[2], silu_f(ya[3]) * yb[3]);
            *(u32x2*)(C.ACT + (size_t)(pm * 256 + k) * DFF + ch) = ov;
        }
    }
    asm volatile("s_waitcnt vmcnt(0)" ::: "memory");
    __syncthreads();
}

__device__ __forceinline__ void phase_final_norm(const Ctx& C) {
    const int gw = C.bid * NWAVES + C.wave, NGW = C.G * NWAVES; const f32x4* gp = (const f32x4*)C.in[I_NFIN] + 2 * C.lane;
    f32x4 gv[4];
#pragma unroll
    for (int j = 0; j < 4; ++j) gv[j] = gp[128 * (j >> 1) + (j & 1)];
    for (int m = gw; m < MT; m += NGW) {
        const float rs = row_rstd(C.PART, m);
        const u32x4* xr = (const u32x4*)(C.XB + (size_t)m * DM) + C.lane;
        f32x4* o = (f32x4*)(C.out + (m < MP ? O_YP + (size_t)m * DM : O_YS + (size_t)(m - MP) * DM)) + 2 * C.lane;
#pragma unroll
        for (int j = 0; j < 2; ++j) { float f[8]; unpack8(xr[64 * j], f);
            o[128 * j] = (f32x4){f[0], f[1], f[2], f[3]} * rs * gv[2 * j]; o[128 * j + 1] = (f32x4){f[4], f[5], f[6], f[7]} * rs * gv[2 * j + 1]; }
    }
}

__device__ __forceinline__ float softplus_f(float x) { return (x > 20.f) ? x : log1pf(__expf(x)); }
template <int NCH> struct ConvRaw { u32x4 h[3]; u32x4 raw[128 * NCH / NTHREADS]; };
template <int NCH> __device__ __forceinline__ void conv_load(const Ctx& C, size_t row0, int t0, int c0, ConvRaw<NCH>& R) {
    constexpr int H = 128 * NCH / NTHREADS;
    int tl = C.tid; asm volatile("" : "+v"(tl));
    const int ch = tl % NCH, r0 = (tl / NCH) * H, cc = c0 + ch * 8;
    const bf16_t* src = C.XBC + (row0 + r0) * NCONV + cc;
    if (t0 + r0 >= 3) { R.h[0] = *(const u32x4*)(src - 3 * NCONV); R.h[1] = *(const u32x4*)(src - 2 * NCONV); R.h[2] = *(const u32x4*)(src - NCONV); }
    else { R.h[0] = (u32x4){0u, 0u, 0u, 0u}; R.h[1] = R.h[0]; R.h[2] = R.h[0]; }
#pragma unroll
    for (int i = 0; i < H; ++i) R.raw[i] = *(const u32x4*)(src + (size_t)i * NCONV);
}
template <int NCH> __device__ __forceinline__ void conv_compute(const Ctx& C, int c0, const ConvRaw<NCH>& R, u32x4 (&outv)[128 * NCH / NTHREADS], float* state) {
    constexpr int H = 128 * NCH / NTHREADS;
    int tl = C.tid; asm volatile("" : "+v"(tl));
    const int ch = tl % NCH, r0 = (tl / NCH) * H, cc = c0 + ch * 8;
    const float* cw = C.in[I_CW] + cc; const float* cb = C.in[I_CB] + cc;
    float w[4][8], bv[8];
#pragma unroll
    for (int k = 0; k < 4; ++k) { const f32x4 a = *(const f32x4*)(cw + k * NCONV), b = *(const f32x4*)(cw + k * NCONV + 4); w[k][0] = a.x; w[k][1] = a.y; w[k][2] = a.z; w[k][3] = a.w; w[k][4] = b.x; w[k][5] = b.y; w[k][6] = b.z; w[k][7] = b.w; }
    { const f32x4 a = *(const f32x4*)cb, b = *(const f32x4*)(cb + 4); bv[0] = a.x; bv[1] = a.y; bv[2] = a.z; bv[3] = a.w; bv[4] = b.x; bv[5] = b.y; bv[6] = b.z; bv[7] = b.w; }
    float a3[8], a2[8], a1[8]; unpack8(R.h[0], a3); unpack8(R.h[1], a2); unpack8(R.h[2], a1);
#pragma unroll
    for (int i = 0; i < H; ++i) {
        float cur[8], o[8]; unpack8(R.raw[i], cur);
#pragma unroll
        for (int e = 0; e < 8; ++e) o[e] = silu_f(bv[e] + w[0][e] * a3[e] + w[1][e] * a2[e] + w[2][e] * a1[e] + w[3][e] * cur[e]);
        outv[i] = pack8(o);
        if (state != nullptr && r0 + i >= 125) { float* op = state + (size_t)(r0 + i - 125) * NCONV + cc; *(f32x4*)op = (f32x4){cur[0], cur[1], cur[2], cur[3]}; *(f32x4*)(op + 4) = (f32x4){cur[4], cur[5], cur[6], cur[7]}; }
#pragma unroll
        for (int e = 0; e < 8; ++e) { a3[e] = a2[e]; a2[e] = a1[e]; a1[e] = cur[e]; }
    }
}
template <int NCH> __device__ __forceinline__ void conv_rows(const Ctx& C, size_t row0, int t0, int c0, u32x4 (&outv)[128 * NCH / NTHREADS], float* state) {
    ConvRaw<NCH> R; conv_load<NCH>(C, row0, t0, c0, R); conv_compute<NCH>(C, c0, R, outv, state);
}
__device__ __forceinline__ void chunk_scan_v(float r0, float r1, float dtb, float A, int lane, float& cs0, float& cs1, float& d0, float& d1, float& tot);
__device__ __forceinline__ void chunk_scan(const float* dtp  , float dtb, float A, int lane, float& cs0, float& cs1, float& d0, float& d1, float& tot) {
    chunk_scan_v(dtp[(size_t)(2 * lane) * 32], dtp[(size_t)(2 * lane + 1) * 32], dtb, A, lane, cs0, cs1, d0, d1, tot);
}
__device__ __forceinline__ void chunk_scan_v(float r0, float r1, float dtb, float A, int lane, float& cs0, float& cs1, float& d0, float& d1, float& tot) {
    d0 = softplus_f(r0 + dtb); d1 = softplus_f(r1 + dtb);
    const float a0 = d0 * A, a1 = d1 * A; float inc = a0 + a1;
#pragma unroll
    for (int o = 1; o < 64; o <<= 1) { const float v = __shfl_up(inc, o); if (lane >= o) inc += v; }
    cs1 = inc; cs0 = inc - a1; tot = __shfl(inc, 63);
}
constexpr int XP = 272, BP = 144;
__device__ __forceinline__ void ssd_states_unit(const Ctx& C, int rb, int g) {
    const int w = C.wave, lane = C.lane, r = w >> 1, phalf = w & 1, h = g * 4 + r, ql = lane & 31, hi = lane >> 5, li = lane & 15, gi = (lane >> 4) & 1;
    LAS bf16_t* Xn = (LAS bf16_t*)C.lds;
    LAS bf16_t* Bn = (LAS bf16_t*)(C.lds + 128 * XP * 2);
    LAS float* F = (LAS float*)(C.lds + 128 * XP * 2 + 128 * BP * 2) + w * 128;
    const size_t row0 = (size_t)rb * 128;
    {   const int t0 = (rb & 31) * 128; float* sto = ((rb & 31) == 31) ? C.out + O_PCONV + (size_t)(rb >> 5) * 3 * NCONV : nullptr;
        u32x4 xv[8]; conv_rows<32>(C, row0, t0, g * 256, xv, sto);
        { const int ch = C.tid & 31, r0 = (C.tid >> 5) * 8;
#pragma unroll
          for (int i = 0; i < 8; ++i) { *(LAS u32x4*)(Xn + (r0 + i) * XP + ch * 8) = xv[i]; *(u32x4*)(C.XC + (row0 + r0 + i) * 3072 + g * 256 + ch * 8) = xv[i]; } }
        u32x4 bvv[4]; conv_rows<16>(C, row0, t0, 2048 + g * 128, bvv, sto);
        { const int ch = C.tid & 15, r0 = (C.tid >> 4) * 4;
#pragma unroll
          for (int i = 0; i < 4; ++i) { *(LAS u32x4*)(Bn + (r0 + i) * BP + ch * 8) = bvv[i]; *(u32x4*)(C.XC + (row0 + r0 + i) * 3072 + 2048 + g * 128 + ch * 8) = bvv[i]; } } }
    const float A = -__expf(C.in[I_ALOG][h]);
    float cs0, cs1, d0, d1, tot; chunk_scan(C.DTRAW + (size_t)(rb * 128) * 32 + h, C.in[I_DTB][h], A, lane, cs0, cs1, d0, d1, tot);
    F[2 * lane] = __expf(tot - cs0) * d0; F[2 * lane + 1] = __expf(tot - cs1) * d1;
    if (phalf == 0 && lane == 0) C.CDEC[rb * 32 + h] = __expf(tot);
    __syncthreads();
    f32x16 acc[4];
#pragma unroll
    for (int nt = 0; nt < 4; ++nt) acc[nt] = zero16();
    const LAS bf16_t* xb = Xn + (8 * hi + (li >> 2)) * XP + r * 64 + phalf * 32 + 16 * gi + 4 * (li & 3);
    const LAS bf16_t* bb = Bn + (8 * hi + (li >> 2)) * BP + 16 * gi + 4 * (li & 3);
#pragma unroll
    for (int s = 0; s < 8; ++s) {
        const s16x4 x0 = lds_tr4(xb + 16 * s * XP), x1 = lds_tr4(xb + (16 * s + 4) * XP);
        const f32x4 f0 = *(const LAS f32x4*)(F + 16 * s + 8 * hi), f1 = *(const LAS f32x4*)(F + 16 * s + 8 * hi + 4);
        u32x4 aw; aw.x = pk2(bf2f((unsigned short)x0[0]) * f0.x, bf2f((unsigned short)x0[1]) * f0.y); aw.y = pk2(bf2f((unsigned short)x0[2]) * f0.z, bf2f((unsigned short)x0[3]) * f0.w);
        aw.z = pk2(bf2f((unsigned short)x1[0]) * f1.x, bf2f((unsigned short)x1[1]) * f1.y); aw.w = pk2(bf2f((unsigned short)x1[2]) * f1.z, bf2f((unsigned short)x1[3]) * f1.w);
        const bf16x8 af = __builtin_bit_cast(bf16x8, aw);
#pragma unroll
        for (int nt = 0; nt < 4; ++nt) { const bf16x8 bfr = cat8(lds_tr4(bb + 16 * s * BP + nt * 32), lds_tr4(bb + (16 * s + 4) * BP + nt * 32)); acc[nt] = MFMA32(af, bfr, acc[nt]); }
    }
    bf16_t* stp = C.ST + ((size_t)(rb * 32 + h) * 64 + phalf * 32) * 128 + ql;
#pragma unroll
    for (int nt = 0; nt < 4; ++nt)
#pragma unroll
        for (int rg = 0; rg < 16; ++rg) stp[(size_t)crow(rg, hi) * 128 + nt * 32] = (bf16_t)(pk2(acc[nt][rg], 0.f) & 0xffffu);
    __syncthreads();
}
__device__ __forceinline__ void ssd_sample_unit(const Ctx& C, int b, int g) {
    LAS float* Bs = (LAS float*)C.lds;
    LAS float* Cs = Bs + 512;
    LAS float* Xs = Cs + 512;
    LAS float* Dts = Xs + 1024;
    LAS float* Css = Dts + 16;
    LAS float* Cbm = Css + 16;
    LAS float* Yt = Cbm + 16;
    LAS float* Red = Yt + 1024;
    const int tid = C.tid, lane = C.lane, w = C.wave; const size_t m0 = (size_t)MP + b * 4;
    const int p = tid >> 3, ns = tid & 7;
    f32x4 hv[4][4];
#pragma unroll
    for (int hl = 0; hl < 4; ++hl) { const float* sin = C.in[I_SSSM] + ((size_t)(b * 32 + g * 4 + hl) * 64 + p) * 128 + ns * 4;
#pragma unroll
        for (int k = 0; k < 4; ++k) hv[hl][k] = __builtin_nontemporal_load((const f32x4*)(sin + 32 * k)); }
    __syncthreads();
    if (tid < 64) {
        const int cc = (tid < 32) ? g * 256 + 8 * tid : (tid < 48) ? 2048 + g * 128 + 8 * (tid - 32) : 3072 + g * 128 + 8 * (tid - 48);
        const float* stp = C.in[I_SCONV] + (size_t)b * 3 * NCONV + cc; const bf16_t* xr = C.XBC + m0 * NCONV + cc; const float* cw = C.in[I_CW] + cc; const float* cb = C.in[I_CB] + cc;
        f32x4 sv[3][2], wv[4][2], bv[2]; u32x4 rw[4];
#pragma unroll
        for (int k = 0; k < 3; ++k) { sv[k][0] = *(const f32x4*)(stp + k * NCONV); sv[k][1] = *(const f32x4*)(stp + k * NCONV + 4); }
#pragma unroll
        for (int k = 0; k < 4; ++k) { rw[k] = *(const u32x4*)(xr + (size_t)k * NCONV); wv[k][0] = *(const f32x4*)(cw + k * NCONV); wv[k][1] = *(const f32x4*)(cw + k * NCONV + 4); }
        bv[0] = *(const f32x4*)cb; bv[1] = *(const f32x4*)(cb + 4);
        float xp[7][8];
#pragma unroll
        for (int k = 0; k < 3; ++k) { xp[k][0] = sv[k][0].x; xp[k][1] = sv[k][0].y; xp[k][2] = sv[k][0].z; xp[k][3] = sv[k][0].w; xp[k][4] = sv[k][1].x; xp[k][5] = sv[k][1].y; xp[k][6] = sv[k][1].z; xp[k][7] = sv[k][1].w; }
#pragma unroll
        for (int k = 0; k < 4; ++k) unpack8(rw[k], xp[3 + k]);
#pragma unroll
        for (int t = 0; t < 4; ++t) {
            float o[8];
#pragma unroll
            for (int e = 0; e < 8; ++e) { float y = (e < 4) ? bv[0][e] : bv[1][e - 4];
#pragma unroll
                for (int k = 0; k < 4; ++k) y += ((e < 4) ? wv[k][0][e] : wv[k][1][e - 4]) * xp[t + k][e];
                o[e] = silu_f(y); }
            LAS float* dst = (tid < 32) ? Xs + ((tid >> 3) * 4 + t) * 64 + 8 * (tid & 7) : (tid < 48) ? Bs + t * 128 + 8 * (tid - 32) : Cs + t * 128 + 8 * (tid - 48);
#pragma unroll
            for (int e = 0; e < 8; ++e) dst[e] = o[e];
            if (t >= 1) { float* so = C.out + O_SCONV + (size_t)(b * 3 + t - 1) * NCONV + cc; *(f32x4*)so = (f32x4){xp[3 + t][0], xp[3 + t][1], xp[3 + t][2], xp[3 + t][3]}; *(f32x4*)(so + 4) = (f32x4){xp[3 + t][4], xp[3 + t][5], xp[3 + t][6], xp[3 + t][7]}; }
        }
    }
    if (tid < 16) Dts[tid] = softplus_f(C.DTRAW[(m0 + (tid & 3)) * 32 + g * 4 + (tid >> 2)] + C.in[I_DTB][g * 4 + (tid >> 2)]);
    __syncthreads();
    if (tid < 4) { const float A = -__expf(C.in[I_ALOG][g * 4 + tid]); float c = 0.f;
#pragma unroll
        for (int t = 0; t < 4; ++t) { c += Dts[tid * 4 + t] * A; Css[tid * 4 + t] = c; } }
    { const int pair = tid >> 5, l32 = tid & 31, t = pair >> 2, s = pair & 3; float a = 0.f;
#pragma unroll
      for (int k = 0; k < 4; ++k) a += Cs[t * 128 + l32 * 4 + k] * Bs[s * 128 + l32 * 4 + k];
#pragma unroll
      for (int o = 1; o < 32; o <<= 1) a += __shfl_xor(a, o);
      if (l32 == 0) Cbm[pair] = a; }
    __syncthreads();
#pragma unroll
    for (int hl = 0; hl < 4; ++hl) {
        const int h = g * 4 + hl; const size_t so = ((size_t)(b * 32 + h) * 64 + p) * 128 + ns * 4;
        float* sout = C.out + O_SSSM + so;
        float cst[4], dtt[4], xv[4], coef[4], yo[4];
#pragma unroll
        for (int t = 0; t < 4; ++t) { cst[t] = Css[hl * 4 + t]; dtt[t] = Dts[hl * 4 + t]; xv[t] = Xs[(hl * 4 + t) * 64 + p]; }
        const float cdec = __expf(cst[3]);
#pragma unroll
        for (int t = 0; t < 4; ++t) { coef[t] = __expf(cst[3] - cst[t]) * dtt[t] * xv[t]; yo[t] = 0.f; }
#pragma unroll
        for (int k = 0; k < 4; ++k) {
            const f32x4 h0 = hv[hl][k]; f32x4 hn = h0 * cdec;
#pragma unroll
            for (int t = 0; t < 4; ++t) {
                const f32x4 cv = *(const LAS f32x4*)(Cs + t * 128 + ns * 4 + 32 * k), bv = *(const LAS f32x4*)(Bs + t * 128 + ns * 4 + 32 * k);
                yo[t] += (cv.x * h0.x + cv.y * h0.y) + (cv.z * h0.z + cv.w * h0.w);
                hn += bv * coef[t];
            }
            __builtin_nontemporal_store(hn, (f32x4*)(sout + 32 * k));
        }
#pragma unroll
        for (int t = 0; t < 4; ++t) { yo[t] += __shfl_xor(yo[t], 1); yo[t] += __shfl_xor(yo[t], 2); yo[t] += __shfl_xor(yo[t], 4); }
        if (ns == 0) {
            const float Dh = C.in[I_SD][h];
#pragma unroll
            for (int t = 0; t < 4; ++t) {
                float y = __expf(cst[t]) * yo[t] + Dh * xv[t];
#pragma unroll
                for (int s = 0; s < 4; ++s) if (s <= t) y += Cbm[t * 4 + s] * __expf(cst[t] - cst[s]) * dtt[s] * xv[s];
                Yt[t * 256 + hl * 64 + p] = y;
            }
        }
    }
    __syncthreads();
    { const int t = tid >> 7, ch = (tid & 127) * 2; const size_t zo = (m0 + t) * DIN + g * 256 + ch;
      const unsigned zz = *(const unsigned*)(C.Z + zo);
      const float v0 = Yt[t * 256 + ch] * silu_f(bf2f(zz & 0xffffu)), v1 = Yt[t * 256 + ch + 1] * silu_f(bf2f(zz >> 16));
      const float ss = wave_sum(v0 * v0 + v1 * v1);
      if (lane == 0) Red[w] = ss;
      __syncthreads();
      const float rn = 1.0f / sqrtf((Red[2 * t] + Red[2 * t + 1]) * (1.0f / 256.0f) + RMS_EPS);
      *(unsigned*)(C.Z + zo) = pk2(v0 * rn, v1 * rn); }
    __syncthreads();
}
constexpr int SSU0 = 0, SSU1 = 1024;
__device__ __forceinline__ void sample_units(const Ctx& C, int lo, int hi) { for (int u = lo + C.bid; u < hi; u += C.G) ssd_sample_unit(C, u >> 3, u & 7); }
__device__ __forceinline__ void phase_ssd_states(const Ctx& C) {
    for (int u = C.bid; u < 1024; u += C.G) ssd_states_unit(C, u >> 3, u & 7);
    sample_units(C, 0, SSU0);
}
__device__ __forceinline__ void phase_ssd_scan(const Ctx& C) {
    const int gt = C.bid * NTHREADS + C.tid, NGT = C.G * NTHREADS;
    for (int id = gt; id < NBATCH * NSH * 64 * 16; id += NGT) {
        const int n8 = id & 15, p = (id >> 4) & 63, h = (id >> 10) & 31, b = id >> 15;
        float hs[8];
#pragma unroll
        for (int e = 0; e < 8; ++e) hs[e] = 0.f;
#pragma unroll 8
        for (int c = 0; c < NCHUNK; ++c) {
            const size_t off = ((size_t)((b * NCHUNK + c) * NSH + h) * 64 + p) * 128 + n8 * 8;
            const u32x4 sv = *(const u32x4*)(C.ST + off);
            *(u32x4*)(C.HP + off) = pack8(hs);
            float s[8]; unpack8(sv, s); const float dec = C.CDEC[(b * NCHUNK + c) * NSH + h];
#pragma unroll
            for (int e = 0; e < 8; ++e) hs[e] = hs[e] * dec + s[e];
        }
        float* op = C.out + O_PSSM + ((size_t)(b * NSH + h) * 64 + p) * 128 + n8 * 8;
        *(f32x4*)op = (f32x4){hs[0], hs[1], hs[2], hs[3]}; *(f32x4*)(op + 4) = (f32x4){hs[4], hs[5], hs[6], hs[7]};
    }
    __syncthreads();
    sample_units(C, SSU0, SSU1);
}
struct S3Pre { ConvRaw<16> Rc; u32x4 bst[4]; float dr0, dr1; };
__device__ __forceinline__ void s3_prefetch(const Ctx& C, int rb, int g, int r, int tid, S3Pre& P) {
    const size_t row0 = (size_t)rb * 128; const int lane = tid & 63;
#pragma unroll
    for (int i = 0; i < 4; ++i) { const int id = i * NTHREADS + tid, s = id >> 4, c2 = id & 15; P.bst[i] = *(const u32x4*)(C.XC + (row0 + s) * 3072 + 2048 + g * 128 + c2 * 8); }
    conv_load<16>(C, row0, (rb & 31) * 128, 3072 + g * 128, P.Rc);
    const float* dtp = C.DTRAW + (size_t)(rb * 128) * 32 + g * 4 + r; P.dr0 = dtp[(size_t)(2 * lane) * 32]; P.dr1 = dtp[(size_t)(2 * lane + 1) * 32];
}
__device__ __forceinline__ void ssd_out_unit(const Ctx& C, int rb, int g, S3Pre& P, bool has_next, int nrb, int ng) {
    int tid = (int)threadIdx.x; asm volatile("" : "+v"(tid));
    const int w = C.wave, lane = tid & 63, r = w >> 1, psel = w & 1, h = g * 4 + r, ql = lane & 31, hi = lane >> 5;
    LAS bf16_t* Cs = (LAS bf16_t*)C.lds;
    LAS f32x4* CBT = (LAS f32x4*)(C.lds + 34816);
    LAS float* CS = (LAS float*)(C.lds + 75776) + r * 256; LAS float* DTL = CS + 128;
    LAS float* SSQ = (LAS float*)(C.lds + 75776 + 4096);
    LAS bf16_t* Bs = (LAS bf16_t*)(C.lds + 81920);
    LAS bf16_t* Xs = (LAS bf16_t*)(C.lds + 81920);
    const size_t row0 = (size_t)rb * 128;
    const int t0 = (rb & 31) * 128;
    {   u32x4 bvv[4]; const int ch = tid & 15, r0 = (tid >> 4) * 4;
#pragma unroll
        for (int i = 0; i < 4; ++i) { const int id = i * NTHREADS + tid, s = id >> 4, c2 = id & 15; *(LAS u32x4*)(Bs + s * 136 + c2 * 8) = P.bst[i]; }
        conv_compute<16>(C, 3072 + g * 128, P.Rc, bvv, ((rb & 31) == 31) ? C.out + O_PCONV + (size_t)(rb >> 5) * 3 * NCONV : nullptr);
#pragma unroll
        for (int i = 0; i < 4; ++i) *(LAS u32x4*)(Cs + (r0 + i) * 136 + ch * 8) = bvv[i];
    }
    u32x4 xst[8];
#pragma unroll
    for (int i = 0; i < 8; ++i) { const int id = i * NTHREADS + tid, t = id >> 5, ch = id & 31; xst[i] = *(const u32x4*)(C.XC + (row0 + t) * 3072 + g * 256 + ch * 8); }

    const float A = -__expf(C.in[I_ALOG][h]), Dh = C.in[I_SD][h];
    { float cs0, cs1, d0, d1, tot; chunk_scan_v(P.dr0, P.dr1, C.in[I_DTB][h], A, lane, cs0, cs1, d0, d1, tot);
      if (psel == 0) { CS[2 * lane] = cs0; CS[2 * lane + 1] = cs1; DTL[2 * lane] = d0; DTL[2 * lane + 1] = d1; } }
    __syncthreads();
    for (int tile = w; tile < 10; tile += NWAVES) {
        const int lt = (tile >= 6) ? 3 : (tile >= 3) ? 2 : (tile >= 1) ? 1 : 0, st = tile - lt * (lt + 1) / 2;
        f32x16 cb = zero16();
#pragma unroll
        for (int k = 0; k < 8; ++k) { const bf16x8 bfr = *(const LAS bf16x8*)(Bs + (32 * st + ql) * 136 + 16 * k + 8 * hi), cfr = *(const LAS bf16x8*)(Cs + (32 * lt + ql) * 136 + 16 * k + 8 * hi); cb = MFMA32(bfr, cfr, cb); }
#pragma unroll
        for (int q4 = 0; q4 < 4; ++q4) CBT[(tile * 4 + q4) * 64 + lane] = (f32x4){cb[4 * q4], cb[4 * q4 + 1], cb[4 * q4 + 2], cb[4 * q4 + 3]};
    }
    __syncthreads();
#pragma unroll
    for (int i = 0; i < 8; ++i) { const int id = i * NTHREADS + tid, t = id >> 5, ch = id & 31; *(LAS u32x4*)(Xs + t * XP + ch * 8) = xst[i]; }
    bf16x8 hf[2][8];
#pragma unroll
    for (int pt = 0; pt < 2; ++pt) { const bf16_t* hp = C.HP + ((size_t)(rb * 32 + h) * 64 + 32 * pt + ql) * 128 + 8 * hi;
#pragma unroll
        for (int k = 0; k < 8; ++k) hf[pt][k] = *(const bf16x8*)(hp + 16 * k); }
    __syncthreads();
    const int li = lane & 15, gi = (lane >> 4) & 1;
    const LAS bf16_t* xt = Xs + (4 * hi + (li >> 2)) * XP + r * 64 + 16 * gi + 4 * (li & 3);
    for (int lq = 0; lq < 2; ++lq) {
        const int lt = psel ? (1 + lq) : (3 * lq), l = 32 * lt + ql; const size_t lrow = row0 + l;
        u32x4 zq[2][2];
#pragma unroll
        for (int pt = 0; pt < 2; ++pt)
#pragma unroll
            for (int j = 0; j < 2; ++j) zq[pt][j] = *(const u32x4*)(C.Z + lrow * DIN + h * 64 + 32 * pt + 16 * j + 8 * hi);
        if (lq == 1 && has_next) s3_prefetch(C, nrb, ng, r, tid, P);
        const float csl = CS[l];
        f32x16 Y[2]; Y[0] = zero16(); Y[1] = zero16();
        for (int st = 0; st <= lt; ++st) {
            const int tile = lt * (lt + 1) / 2 + st;
            float wv[16];
#pragma unroll
            for (int q4 = 0; q4 < 4; ++q4) {
                const int sb = 32 * st + 8 * q4 + 4 * hi;
                const f32x4 cb4 = CBT[(tile * 4 + q4) * 64 + lane];
                const f32x4 cs4 = *(const LAS f32x4*)(CS + sb), dt4 = *(const LAS f32x4*)(DTL + sb);
#pragma unroll
                for (int e = 0; e < 4; ++e) { const int s = sb + e; float v = cb4[e] * __expf(csl - cs4[e]) * dt4[e]; v = (s <= l) ? v : 0.f; if (s == l) v += Dh; wv[4 * q4 + e] = v; }
            }
            bf16x8 pf[2];
#pragma unroll
            for (int ks = 0; ks < 2; ++ks) { u32x4 pw; pw.x = pk2(wv[8 * ks], wv[8 * ks + 1]); pw.y = pk2(wv[8 * ks + 2], wv[8 * ks + 3]); pw.z = pk2(wv[8 * ks + 4], wv[8 * ks + 5]); pw.w = pk2(wv[8 * ks + 6], wv[8 * ks + 7]); pf[ks] = __builtin_bit_cast(bf16x8, pw); }
#pragma unroll
            for (int pt = 0; pt < 2; ++pt)
#pragma unroll
                for (int ks = 0; ks < 2; ++ks) {
                    const LAS bf16_t* xp = xt + (32 * st + 16 * ks) * XP + pt * 32;
                    const bf16x8 xf = cat8(lds_tr4(xp), lds_tr4(xp + 8 * XP));
                    Y[pt] = MFMA32(xf, pf[ks], Y[pt]);
                }
        }
        const float el = __expf(csl);
        bf16x8 cf[8];
#pragma unroll
        for (int k = 0; k < 8; ++k) cf[k] = *(const LAS bf16x8*)(Cs + l * 136 + 16 * k + 8 * hi);
#pragma unroll
        for (int pt = 0; pt < 2; ++pt) {
            f32x16 y2 = zero16();
#pragma unroll
            for (int k = 0; k < 8; ++k) y2 = MFMA32(hf[pt][k], cf[k], y2);
#pragma unroll
            for (int rg = 0; rg < 16; ++rg) Y[pt][rg] += el * y2[rg];
        }
        float ss = 0.f;
#pragma unroll
        for (int pt = 0; pt < 2; ++pt)
#pragma unroll
            for (int q4 = 0; q4 < 4; ++q4) {
                u32x2 z2;
                { const u32x4 zv = zq[pt][q4 >> 1];
                  auto s0 = __builtin_amdgcn_permlane32_swap(zv.x, zv.z, false, false); auto s1 = __builtin_amdgcn_permlane32_swap(zv.y, zv.w, false, false);
                  z2.x = (q4 & 1) ? s0[1] : s0[0]; z2.y = (q4 & 1) ? s1[1] : s1[0]; }
                const float z0 = bf2f(z2.x & 0xffffu), z1 = bf2f(z2.x >> 16), z2f = bf2f(z2.y & 0xffffu), z3 = bf2f(z2.y >> 16);
                float v;
                v = Y[pt][4 * q4 + 0] * silu_f(z0); Y[pt][4 * q4 + 0] = v; ss += v * v;
                v = Y[pt][4 * q4 + 1] * silu_f(z1); Y[pt][4 * q4 + 1] = v; ss += v * v;
                v = Y[pt][4 * q4 + 2] * silu_f(z2f); Y[pt][4 * q4 + 2] = v; ss += v * v;
                v = Y[pt][4 * q4 + 3] * silu_f(z3); Y[pt][4 * q4 + 3] = v; ss += v * v;
            }
        ss += __shfl_xor(ss, 32);
        if (hi == 0) SSQ[r * 128 + l] = ss;
        __syncthreads();
        const float tot = (SSQ[l] + SSQ[128 + l]) + (SSQ[256 + l] + SSQ[384 + l]);
        const float rn = 1.0f / sqrtf(tot * (1.0f / 256.0f) + RMS_EPS);
#pragma unroll
        for (int pt = 0; pt < 2; ++pt)
#pragma unroll
            for (int j = 0; j < 2; ++j) {
                const int qa = 2 * j, qb = 2 * j + 1;
                const unsigned x0 = pk2(Y[pt][4 * qa] * rn, Y[pt][4 * qa + 1] * rn), x1 = pk2(Y[pt][4 * qa + 2] * rn, Y[pt][4 * qa + 3] * rn);
                const unsigned y0 = pk2(Y[pt][4 * qb] * rn, Y[pt][4 * qb + 1] * rn), y1 = pk2(Y[pt][4 * qb + 2] * rn, Y[pt][4 * qb + 3] * rn);
                auto s0 = __builtin_amdgcn_permlane32_swap(x0, y0, false, false); auto s1 = __builtin_amdgcn_permlane32_swap(x1, y1, false, false);
                u32x4 ov; ov.x = s0[0]; ov.y = s1[0]; ov.z = s0[1]; ov.w = s1[1];
                *(u32x4*)(C.Z + lrow * DIN + h * 64 + 32 * pt + 16 * j + 8 * hi) = ov;
            }
    }
    __syncthreads();
}
__device__ __forceinline__ void phase_ssd_out(const Ctx& C) {
    { int u = C.bid; if (u < 1024) { S3Pre P; int t0_ = (int)threadIdx.x; asm volatile("" : "+v"(t0_)); s3_prefetch(C, u >> 3, u & 7, C.wave >> 1, t0_, P);
          for (; u < 1024; u += C.G) { const int nu = u + C.G; ssd_out_unit(C, u >> 3, u & 7, P, nu < 1024, nu >> 3, nu & 7); } } }
    sample_units(C, SSU1, 1024);
}
template <int K> __device__ __forceinline__ void skinny_resid(const Ctx& C, const bf16_t* A, const bf16_t* Bt) {
    constexpr int KC = 256, NCK = K / KC, SP = KC + 8, BUF = 96 * SP;
    static_assert(K % KC == 0, "K chunks");
    LAS bf16_t* buf = (LAS bf16_t*)C.lds;
    LAS float* red = (LAS float*)(C.lds + 2 * BUF * 2);
    int tid = (int)threadIdx.x; asm volatile("" : "+v"(tid));
    const int w = C.wave, lane = tid & 63, r16 = lane & 15, kq = lane >> 4, rt = w >> 2, ct = w & 3;
    for (int pc = C.bid; pc < 256; pc += C.G) {
        const int rg = pc >> 4, cgp = pc & 15;
        const bf16_t* src[6]; int dsto[6];
#pragma unroll
        for (int i = 0; i < 6; ++i) { const int id = i * NTHREADS + tid, row = id >> 5, ch = id & 31;
            src[i] = (row < 32 ? A + (size_t)(MP + 32 * rg + row) * K : Bt + (size_t)(64 * cgp + row - 32) * K) + ch * 8; dsto[i] = row * SP + ch * 8; }
        u32x4 st[2][6];
#pragma unroll
        for (int i = 0; i < 6; ++i) st[0][i] = *(const u32x4*)src[i];
        if (NCK > 1) {
#pragma unroll
            for (int i = 0; i < 6; ++i) st[1][i] = *(const u32x4*)(src[i] + KC); }
#pragma unroll
        for (int i = 0; i < 6; ++i) *(LAS u32x4*)(buf + dsto[i]) = st[0][i];
        __syncthreads();
        f32x4 acc = (f32x4){0.f, 0.f, 0.f, 0.f};
#pragma unroll
        for (int kc = 0; kc < NCK; ++kc) {
            if (kc + 2 < NCK) {
#pragma unroll
                for (int i = 0; i < 6; ++i) st[kc & 1][i] = *(const u32x4*)(src[i] + (size_t)(kc + 2) * KC); }
            const LAS bf16_t* ab = buf + (kc & 1) * BUF + (rt * 16 + r16) * SP + 8 * kq; const LAS bf16_t* bb = buf + (kc & 1) * BUF + (32 + ct * 16 + r16) * SP + 8 * kq;
#pragma unroll
            for (int ks = 0; ks < 8; ++ks) { const bf16x8 af = *(const LAS bf16x8*)(ab + 32 * ks), bfr = *(const LAS bf16x8*)(bb + 32 * ks); acc = __builtin_amdgcn_mfma_f32_16x16x32_bf16(bfr, af, acc, 0, 0, 0); }
            if (kc + 1 < NCK) {
#pragma unroll
                for (int i = 0; i < 6; ++i) *(LAS u32x4*)(buf + ((kc + 1) & 1) * BUF + dsto[i]) = st[(kc + 1) & 1][i]; }
            __syncthreads();
        }
        {
            const int srow = 32 * rg + rt * 16 + r16, col = 64 * cgp + 16 * ct + 4 * kq; const size_t grow = (size_t)MP + srow;
            const u32x2 ow = *(const u32x2*)(C.XB + grow * DM + col);
            f32x4 v = acc + (f32x4){bf2f(ow.x & 0xffffu), bf2f(ow.x >> 16), bf2f(ow.y & 0xffffu), bf2f(ow.y >> 16)};
            float ss = (v.x * v.x + v.y * v.y) + (v.z * v.z + v.w * v.w);
            ss += __shfl_xor(ss, 16); ss += __shfl_xor(ss, 32);
            u32x2 wv; wv.x = pk2(v.x, v.y); wv.y = pk2(v.z, v.w); *(u32x2*)(C.XB + grow * DM + col) = wv;
            if (kq == 0) red[(rt * 4 + ct) * 16 + r16] = ss;
        }
        __syncthreads();
        if (tid < 32) { const int rr = tid; const LAS float* rp = red + (rr >> 4) * 64 + (rr & 15);
            C.PART[((size_t)MP + 32 * rg + rr) * 16 + cgp] = (rp[0] + rp[16]) + (rp[32] + rp[48]); }
        __syncthreads();
    }
}
#define RLX_AGENT __ATOMIC_RELAXED, __HIP_MEMORY_SCOPE_AGENT
#define XB_TMO      128
#define XB_XCNT(j)  (256  + 64 * (j))
#define XB_XSUB(j)  (1280 + 64 * (j))
#define XB_XGEN(j)  (2304 + 64 * (j))
#define XB_TOP      3328
#define XB_TOPGEN   3392
#define XCD_BAR_WORDS 3456
#define XB_SPIN_CAP (1u << 18)

__device__ __forceinline__ unsigned xb_ld(unsigned* p)              { return __hip_atomic_load(p, __ATOMIC_RELAXED, __HIP_MEMORY_SCOPE_AGENT); }
__device__ __forceinline__ unsigned xb_add(unsigned* p, unsigned v) { return __hip_atomic_fetch_add(p, v, __ATOMIC_RELAXED, __HIP_MEMORY_SCOPE_AGENT); }
__device__ __forceinline__ unsigned xb_xcc_id() { return (unsigned)__builtin_amdgcn_s_getreg((3 << 11) | 20) & 0xFu; }
#define XB_SPIN(cond, bar) do { unsigned _sp = 0; while (cond) { __builtin_amdgcn_s_sleep(1); \
    if ((++_sp & 255u) == 0u) { if (xb_ld(&(bar)[XB_TMO])) break; if (_sp > XB_SPIN_CAP) { atomicAdd(&(bar)[XB_TMO], 1u); break; } } } } while (0)

struct XcdBarrier {
    unsigned* bar; unsigned x;
    volatile LAS unsigned* st;
};

__device__ __forceinline__ XcdBarrier xcd_barrier_post(unsigned* bar, volatile LAS unsigned* st) {
    XcdBarrier b; b.bar = bar; b.x = xb_xcc_id(); b.st = st;
    if (threadIdx.x == 0) (void)xb_add(&bar[XB_XCNT(b.x)], 1u);
    return b;
}
__device__ __forceinline__ void xcd_barrier_complete(unsigned* bar, unsigned x, unsigned& nloc, unsigned& nx) {
    const unsigned G = gridDim.x * gridDim.y * gridDim.z;
    unsigned sum, cnt, mine, sp = 0u;
    for (;;) {
        sum = 0u; cnt = 0u; mine = 0u;
#pragma unroll
        for (unsigned j = 0; j < 16; ++j) { const unsigned c = xb_ld(&bar[XB_XCNT(j)]); sum += c; cnt += (c > 0u) ? 1u : 0u; mine = (j == x) ? c : mine; }
        if (sum == G) break;
        __builtin_amdgcn_s_sleep(1);
        if ((++sp & 255u) == 0u) { if (xb_ld(&bar[XB_TMO])) break; if (sp > XB_SPIN_CAP) { atomicAdd(&bar[XB_TMO], 1u); break; } }
    }
    nloc = mine > 0u ? mine : 1u; nx = cnt > 0u ? cnt : 1u;
}

__device__ __forceinline__ void xcd_barrier(const XcdBarrier& b) {
    asm volatile("s_waitcnt vmcnt(0)" ::: "memory");
    __syncthreads();
    if (threadIdx.x == 0) {
        unsigned* bar = b.bar;
        __builtin_amdgcn_s_waitcnt(0);
        unsigned nloc = b.st[0], nx = b.st[1];
        if (nloc == 0u) { xcd_barrier_complete(bar, b.x, nloc, nx); b.st[0] = nloc; b.st[1] = nx; }
        const unsigned old = xb_add(&bar[XB_XSUB(b.x)], 1u);
        const unsigned gen = old / nloc;
        if (old + 1u == (gen + 1u) * nloc) {
            __builtin_amdgcn_fence(__ATOMIC_RELEASE, "agent");
            asm volatile("s_waitcnt vmcnt(0)" ::: "memory");
            const unsigned og = xb_add(&bar[XB_TOP], 1u);
            const unsigned tg = og / nx;
            if (og + 1u == (tg + 1u) * nx) xb_add(&bar[XB_TOPGEN], 1u);
            else XB_SPIN(xb_ld(&bar[XB_TOPGEN]) == tg, bar);
            __builtin_amdgcn_fence(__ATOMIC_ACQUIRE, "agent");
            xb_add(&bar[XB_XGEN(b.x)], 1u);
            asm volatile("s_waitcnt vmcnt(0)" ::: "memory");
        } else {
            XB_SPIN(xb_ld(&bar[XB_XGEN(b.x)]) == gen, bar);
            __builtin_amdgcn_fence(__ATOMIC_ACQUIRE, "agent");
            asm volatile("s_waitcnt vmcnt(0)" ::: "memory");
        }
    }
    __syncthreads();
}

#ifndef MK_ONE_LAUNCH
#define MK_ONE_LAUNCH 1
#endif
constexpr int N_PHASES = 17;
template <class Epi> __device__ __forceinline__ void run_gemm(const Ctx& C, const bf16_t* A, const bf16_t* Bt, int N, int K, const Epi& E, int M = MT) {
    pg8::Gemm g{A, Bt, M, N, K}; pg8::StaticOrder S; S.init(M, N, C.G, C.bid);
    if constexpr (Epi::NEEDS_RSTD) pg8::phase_rstd_table(E.part, S, E.RS);
    pg8::gemm_phase<Epi, pg8::StaticOrder, true, true>(C.lds, g, S, E);
}
__global__ void __launch_bounds__(NTHREADS, 2) hybrid_fwd(Args a) {
    extern __shared__ __attribute__((aligned(16))) unsigned char lds_raw[];
    Ctx C;
#pragma unroll
    for (int i = 0; i < 26; ++i) C.in[i] = a.in[i];
    C.out = a.out; C.ws = a.ws; C.lds = (LAS unsigned char*)lds_raw;
    C.tid = threadIdx.x; C.lane = C.tid & 63; C.wave = __builtin_amdgcn_readfirstlane(C.tid >> 6); C.G = gridDim.x; C.bid = blockIdx.x;
    unsigned char* ws = a.ws;
    C.PART = (float*)(ws + WS_PART); C.BIASD = (float*)(ws + WS_BIASD); C.CDEC = (float*)(ws + WS_CDEC); C.DTRAW = (float*)(ws + WS_DTRAW); C.U0 = (float*)(ws + WS_U0); C.UL = (float*)(ws + WS_UL);
    C.WQKV = (bf16_t*)(ws + WS_WQKV); C.WO = (bf16_t*)(ws + WS_WO); C.WIN = (bf16_t*)(ws + WS_WIN); C.WOUT = (bf16_t*)(ws + WS_WOUT); C.WUP = (bf16_t*)(ws + WS_WUP); C.WDN = (bf16_t*)(ws + WS_WDN);
    C.XB = (bf16_t*)(ws + WS_XB); C.QKV = (bf16_t*)(ws + WS_QKV); C.AO = (bf16_t*)(ws + WS_AO); C.ACT = (bf16_t*)(ws + WS_ACT); C.Z = (bf16_t*)(ws + WS_Z); C.XBC = (bf16_t*)(ws + WS_XBC);
    C.ST = (bf16_t*)(ws + WS_ST); C.HP = (bf16_t*)(ws + WS_HP); C.XC = (bf16_t*)(ws + WS_XC);
    const int lo = a.ph_lo, hi = a.ph_hi;
    volatile LAS unsigned* MISC = (volatile LAS unsigned*)(C.lds + LDSCTL_OFF);
    if (C.tid < 16) MISC[C.tid] = 0u;
    __syncthreads();
    XcdBarrier bar; bar.bar = (unsigned*)(ws + WS_CTL); bar.x = 0; bar.st = nullptr;
    if (a.coop) bar = xcd_barrier_post((unsigned*)(ws + WS_CTL), MISC + 8);
#define IN(k) (lo <= (k) && (k) < hi)
#define FRESH() do { int t_ = threadIdx.x; asm volatile("" : "+v"(t_)); C.tid = t_; C.lane = t_ & 63; C.wave = __builtin_amdgcn_readfirstlane(t_ >> 6); } while (0)
#ifndef CG_SEAM_MASK
#define CG_SEAM_MASK 0x0u
#endif
#define SEAM(k) do { if (IN(k) && IN((k) + 1)) { if ((CG_SEAM_MASK >> (k)) & 1u) cg::this_grid().sync(); else xcd_barrier(bar); } } while (0)
    if (IN(0)) { FRESH(); phase_prologue(C);  __syncthreads(); } SEAM(0);
    if (IN(1)) { FRESH(); pg8::EpiScale<0> E{C.PART, C.QKV, NQKV, nullptr, nullptr, (LAS float*)(C.lds + RING_BYTES + 16384)}; run_gemm(C, C.XB, C.WQKV, NQKV, DM, E); convert_in_tail<1>(C, (MT / 256) * (NQKV / 256));  __syncthreads(); } SEAM(1);
    if (IN(2)) { FRESH(); phase_attention(C);  __syncthreads(); } SEAM(2);
    if (IN(3)) { FRESH(); pg8::EpiResid E{C.XB, C.PART}; run_gemm(C, C.AO, C.WO, DM, DM, E, MP); skinny_resid<DM>(C, C.AO, C.WO);  __syncthreads(); } SEAM(3);
    if (IN(4)) { FRESH(); pg8::EpiConvAct E{C.PART, C.ACT, C.in[I_FCW], C.in[I_FCB], C.in[I_SFFN], C.U0, C.UL, C.out + O_PFFN, C.out + O_SFFN, (LAS float*)(C.lds + RING_BYTES), (LAS float*)(C.lds + RING_BYTES + 16384), (LAS float*)(C.lds + RING_BYTES + 8192)}; run_gemm(C, C.XB, C.WUP, NUP, DM, E); convert_in_tail<2>(C, (MT / 256) * (NUP / 256));  __syncthreads(); } SEAM(4);
    if (IN(6)) { FRESH(); { pg8::StaticOrder S_; pg8::Unit u_; S_.init(MP, DM, C.G, C.bid); for (int i_ = 0; S_.next(i_, u_); ++i_) ffn_fixup_tile(C, 0, u_.pm); } pg8::EpiResid E{C.XB, C.PART}; run_gemm(C, C.ACT, C.WDN, DM, DFF, E, MP); skinny_resid<DFF>(C, C.ACT, C.WDN);  __syncthreads(); } SEAM(6);
    if (IN(7)) { FRESH(); pg8::EpiScale<2> E{C.PART, C.Z, DIN, C.XBC, C.DTRAW, (LAS float*)(C.lds + RING_BYTES + 16384)}; run_gemm(C, C.XB, C.WIN, NINP, DM, E); convert_in_tail<3>(C, (MT / 256) * (NINP / 256));  __syncthreads(); } SEAM(7);
    if (IN(9)) { FRESH(); phase_ssd_states(C);  __syncthreads(); } SEAM(9);
    if (IN(10)) { FRESH(); phase_ssd_scan(C);  __syncthreads(); } SEAM(10);
    if (IN(11)) { FRESH(); phase_ssd_out(C);  __syncthreads(); } SEAM(11);
    if (IN(12)) { FRESH(); pg8::EpiResid E{C.XB, C.PART}; run_gemm(C, C.Z, C.WOUT, DM, DIN, E, MP); skinny_resid<DIN>(C, C.Z, C.WOUT);  __syncthreads(); } SEAM(12);
    if (IN(13)) { FRESH(); pg8::EpiConvAct E{C.PART, C.ACT, C.in[I_FCW] + 3 * NUP, C.in[I_FCB] + NUP, C.in[I_SFFN] + (size_t)SBATCH * 2 * NUP, C.U0, C.UL, C.out + O_PFFN + 4 * 2 * NUP, C.out + O_SFFN + (size_t)SBATCH * 2 * NUP, (LAS float*)(C.lds + RING_BYTES), (LAS float*)(C.lds + RING_BYTES + 16384), (LAS float*)(C.lds + RING_BYTES + 8192)}; run_gemm(C, C.XB, C.WUP + (size_t)NUP * DM, NUP, DM, E); convert_in_tail<4>(C, (MT / 256) * (NUP / 256));  __syncthreads(); } SEAM(13);
    if (IN(15)) { FRESH(); { pg8::StaticOrder S_; pg8::Unit u_; S_.init(MP, DM, C.G, C.bid); for (int i_ = 0; S_.next(i_, u_); ++i_) ffn_fixup_tile(C, 1, u_.pm); } pg8::EpiResid E{C.XB, C.PART}; run_gemm(C, C.ACT, C.WDN + (size_t)DM * DFF, DM, DFF, E, MP); skinny_resid<DFF>(C, C.ACT, C.WDN + (size_t)DM * DFF);  __syncthreads(); } SEAM(15);
    if (IN(16)) { FRESH(); phase_final_norm(C); __syncthreads(); }
#undef IN
#undef SEAM
}

extern "C" void kernel_launch(void* const* d_in, const int* in_sizes, int n_in, void* d_out, int out_size, void* d_ws, size_t ws_size, hipStream_t stream) {
    static int grid = 0;
    if (grid == 0) {
        if (n_in != 26 || (size_t)out_size != O_END || ws_size < WS_END) { fprintf(stderr, "kernel_launch: unexpected problem: n_in %d out %d ws %zu (need %zu)\n", n_in, out_size, ws_size, (size_t)WS_END); grid = -1; return; }
        int dev = 0, cus = 0, per_cu = 0;
        if (hipGetDevice(&dev) != hipSuccess || hipDeviceGetAttribute(&cus, hipDeviceAttributeMultiprocessorCount, dev) != hipSuccess) { grid = -1; return; }
        if (hipFuncSetAttribute((const void*)hybrid_fwd, hipFuncAttributeMaxDynamicSharedMemorySize, LDS_BYTES) != hipSuccess) { fprintf(stderr, "kernel_launch: hipFuncSetAttribute failed\n"); grid = -1; return; }
        if (hipOccupancyMaxActiveBlocksPerMultiprocessor(&per_cu, (const void*)hybrid_fwd, NTHREADS, LDS_BYTES) != hipSuccess || per_cu < 1) { fprintf(stderr, "kernel_launch: occupancy query says %d\n", per_cu); per_cu = 1; (void)hipGetLastError(); }
        grid = cus * (per_cu > 1 ? 1 : per_cu);
    }
    if (grid < 0) return;
    Args a{};
    for (int i = 0; i < 26; ++i) a.in[i] = (const float*)d_in[i];
    a.out = (float*)d_out; a.ws = (unsigned char*)d_ws;
#if MK_ONE_LAUNCH
    if (hipMemsetAsync((char*)d_ws + WS_CTL, 0, 16384, stream) != hipSuccess) { fprintf(stderr, "kernel_launch: memset failed\n"); return; }
    a.ph_lo = 0; a.ph_hi = N_PHASES; a.coop = 1;
    void* args[] = {&a};
    hipError_t e = hipLaunchCooperativeKernel((const void*)hybrid_fwd, dim3(grid), dim3(NTHREADS), args, LDS_BYTES, stream);
    if (e != hipSuccess) fprintf(stderr, "kernel_launch: cooperative launch failed: %s (grid %d)\n", hipGetErrorString(e), grid);
#else
    for (int p = 0; p < N_PHASES; ++p) {
        a.ph_lo = p; a.ph_hi = p + 1; a.coop = 0;
        hipLaunchKernelGGL(hybrid_fwd, dim3(grid), dim3(NTHREADS), LDS_BYTES, stream, a);
    }
#endif
}
```
